# Optimizing an MI355X kernel written in HIP

```python
import math
import jax, jax.numpy as jnp
from jax import lax
import numpy as np


D_MODEL = 4096
BATCH = 1
SEQ = 16384
DEPTH = 4

BLOCK = 128

POOL_WIDTH = D_MODEL // 4
POOL_WINDOWS = (2, 4, 8, 16)
POOL_GROUP = POOL_WIDTH // len(POOL_WINDOWS)

DIL_WIDTH = D_MODEL // 4
DIL_HEAD_DIM = 128
DIL_HEADS = DIL_WIDTH // DIL_HEAD_DIM
DIL_PATTERNS = ((128, 1), (512, 4), (2048, 16))
N_BUCKETS = 32
T5_MAX_DIST = 2048

CONV_WIDTH = D_MODEL // 4
CONV_TAPS = 3

MLA_V_DIM = 128
MLA_NOPE_DIM = 128
MLA_ROPE_DIM = 64
MLA_HEADS = (D_MODEL - POOL_WIDTH - DIL_WIDTH - CONV_WIDTH) // MLA_V_DIM
MLA_Q_RANK = 3 * D_MODEL // 16
MLA_KV_RANK = D_MODEL // 8
ROPE_THETA = 10000.0

MIX_WIDTH = POOL_WIDTH + DIL_WIDTH + CONV_WIDTH + MLA_HEADS * MLA_V_DIM
IN_SIZES = (POOL_WIDTH, DIL_WIDTH, DIL_WIDTH, DIL_WIDTH, CONV_WIDTH, CONV_WIDTH, CONV_WIDTH,
            MLA_Q_RANK, MLA_KV_RANK, MLA_ROPE_DIM)
IN_WIDTH = sum(IN_SIZES)

FFN_HIDDEN = -(-8 * D_MODEL // (3 * 256)) * 256

DEEPNORM_ALPHA = (2 * DEPTH) ** 0.25
DEEPNORM_BETA = (8 * DEPTH) ** -0.25
LN_EPS = 1e-5
RMS_EPS = 1e-6

kernel_name = "hybrid_pool_dilated_conv_mla_deepnorm"


def _layernorm(x, g, b):
    xf = x.astype(jnp.float32)
    mu = xf.mean(-1, keepdims=True)
    var = jnp.square(xf - mu).mean(-1, keepdims=True)
    return ((xf - mu) * lax.rsqrt(var + LN_EPS) * g.astype(jnp.float32) + b.astype(jnp.float32)).astype(x.dtype)


def _rmsnorm(x, g):
    xf = x.astype(jnp.float32)
    y = xf * lax.rsqrt(jnp.square(xf).mean(-1, keepdims=True) + RMS_EPS)
    return (y * g.astype(jnp.float32)).astype(x.dtype)


def _rotate(t, cos, sin):
    half = t.shape[-1] // 2
    t1, t2 = t[..., :half], t[..., half:]
    return jnp.concatenate([t1 * cos - t2 * sin, t1 * sin + t2 * cos], axis=-1)


def _t5_bucket(dist):
    exact = N_BUCKETS // 2
    d = jnp.maximum(dist, 1).astype(jnp.float32)
    large = exact + (jnp.log(d / exact) / math.log(T5_MAX_DIST / exact) * (N_BUCKETS - exact)).astype(jnp.int32)
    return jnp.where(dist < exact, dist, jnp.minimum(large, N_BUCKETS - 1))


def pool_mixer(u, w_pool, scale):
    b, s, c = u.shape
    uf = u.astype(jnp.float32)
    cs = jnp.concatenate([jnp.zeros((b, 1, c), jnp.float32), jnp.cumsum(uf, axis=1)], axis=1)
    t = jnp.arange(s)
    diffs = []
    for g, w in enumerate(POOL_WINDOWS):
        sl = slice(g * POOL_GROUP, (g + 1) * POOL_GROUP)
        csg = cs[:, :, sl]
        lower = jnp.pad(csg, ((0, 0), (w - 1, 0), (0, 0)))[:, :s]
        count = jnp.minimum(t + 1, w).astype(jnp.float32)[None, :, None]
        diffs.append((csg[:, 1:] - lower) / count - uf[:, :, sl])
    d = jnp.stack(diffs, axis=2).astype(u.dtype)
    y = jnp.einsum('bsgc,gcd->bsgd', d, w_pool).reshape(b, s, c)
    return y * scale


def _dilated_branch(q, k, v, t5_bias, window, dilation):
    b, s, h, e = q.shape
    length = s // dilation
    nb = length // BLOCK

    def to_res(t):
        return t.reshape(b, length, dilation, h, e).transpose(0, 2, 1, 3, 4).reshape(b, dilation, nb, BLOCK, h, e)

    def band(t):
        prev = jnp.concatenate([jnp.zeros_like(t[:, :, :1]), t[:, :, :-1]], axis=2)
        return jnp.concatenate([prev, t], axis=3)

    qr = to_res(q)
    kb, vb = band(to_res(k)), band(to_res(v))
    steps = window // dilation
    qi = jnp.arange(BLOCK)[:, None]
    ki = jnp.arange(2 * BLOCK)[None, :]
    dist = qi + BLOCK - ki
    key_step = jnp.arange(nb)[:, None, None] * BLOCK - BLOCK + ki[None]
    valid = (dist >= 0) & (dist <= steps) & (key_step >= 0)
    bias = t5_bias[_t5_bucket(jnp.clip(dist, 0) * dilation)]
    bias = jnp.moveaxis(bias, -1, 0)[:, None].astype(jnp.float32)
    logits = jnp.einsum('brnqhe,brnkhe->brhnqk', qr, kb).astype(jnp.float32) * (e ** -0.5) + bias
    logits = jnp.where(valid, logits, -jnp.inf)
    m = logits.max(-1)
    p = jnp.exp(logits - m[..., None])
    den = p.sum(-1)
    num = jnp.einsum('brhnqk,brnkhe->brnqhe', p.astype(v.dtype), vb).astype(jnp.float32)

    def back(t):
        return t.reshape(b, dilation, length, h, -1).transpose(0, 2, 1, 3, 4).reshape(b, s, h, -1)

    def stat(t):
        return back(jnp.moveaxis(t, 2, -1)[..., None])[..., 0]

    return back(num), stat(m), stat(den)


def dilated_attention(q, k, v, t5_bias):
    s = q.shape[1]
    span = max(d for _, d in DIL_PATTERNS) * BLOCK
    pad = (-s) % span
    padf = lambda t: jnp.pad(t, ((0, 0), (0, pad), (0, 0), (0, 0)))
    qp, kp, vp = padf(q), padf(k), padf(v)
    branches = [_dilated_branch(qp, kp, vp, t5_bias, w, d) for w, d in DIL_PATTERNS]
    m_all = jnp.stack([br[1] for br in branches])
    wts = jnp.exp(m_all - m_all.max(0))
    num = sum(wts[i][..., None] * branches[i][0] for i in range(len(branches)))
    den = sum(wts[i] * branches[i][2] for i in range(len(branches)))
    out = num / den[..., None]
    return out[:, :s].astype(q.dtype)


def short_conv(h, bg, cg, conv_w):
    z = cg * h
    s = z.shape[1]
    zp = jnp.pad(z, ((0, 0), (CONV_TAPS - 1, 0), (0, 0)))
    y = conv_w[0] * zp[:, 0:s]
    for i in range(1, CONV_TAPS):
        y = y + conv_w[i] * zp[:, i:i + s]
    return bg * y


def mla(cq, ckv, kr, q_norm_g, w_uq, kv_norm_g, w_ukv):
    b, s, _ = cq.shape
    hq = MLA_NOPE_DIM + MLA_ROPE_DIM
    q = (_rmsnorm(cq, q_norm_g) @ w_uq).reshape(b, s, MLA_HEADS, hq)
    kv = (_rmsnorm(ckv, kv_norm_g) @ w_ukv).reshape(b, s, MLA_HEADS, MLA_NOPE_DIM + MLA_V_DIM)
    q_nope, q_rope = q[..., :MLA_NOPE_DIM], q[..., MLA_NOPE_DIM:]
    k_nope, v = kv[..., :MLA_NOPE_DIM], kv[..., MLA_NOPE_DIM:]
    pos = jnp.arange(s, dtype=jnp.float32)
    inv = ROPE_THETA ** (-jnp.arange(0, MLA_ROPE_DIM, 2, dtype=jnp.float32) / MLA_ROPE_DIM)
    ang = pos[:, None] * inv[None, :]
    cos, sin = jnp.cos(ang).astype(q.dtype), jnp.sin(ang).astype(q.dtype)
    q_rope = _rotate(q_rope, cos[None, :, None], sin[None, :, None])
    k_rope = _rotate(kr, cos[None], sin[None])
    nq = s // BLOCK
    qn_blk = q_nope.reshape(b, nq, BLOCK, MLA_HEADS, MLA_NOPE_DIM).transpose(1, 0, 2, 3, 4)
    qr_blk = q_rope.reshape(b, nq, BLOCK, MLA_HEADS, MLA_ROPE_DIM).transpose(1, 0, 2, 3, 4)
    key_pos = jnp.arange(s)
    scale = hq ** -0.5

    def attend(args):
        qn, qrb, i = args
        logits = (jnp.einsum('bqhe,bkhe->bhqk', qn, k_nope)
                  + jnp.einsum('bqhe,bke->bhqk', qrb, k_rope)).astype(jnp.float32) * scale
        qpos = i * BLOCK + jnp.arange(BLOCK)
        logits = jnp.where(key_pos[None, :] <= qpos[:, None], logits, -jnp.inf)
        p = jax.nn.softmax(logits, axis=-1).astype(v.dtype)
        return jnp.einsum('bhqk,bkhe->bqhe', p, v)

    out = lax.map(attend, (qn_blk, qr_blk, jnp.arange(nq)))
    return out.transpose(1, 0, 2, 3, 4).reshape(b, s, MLA_HEADS * MLA_V_DIM)


def setup_inputs(seed: int = 0) -> dict:
    key = jax.random.key(seed)
    ks = jax.random.split(key, 18)
    f32 = jnp.float32

    def nrm(k, shape, scale):
        return jax.random.normal(k, shape, f32) * scale

    L = DEPTH
    return {
        "x": nrm(ks[0], (BATCH, SEQ, D_MODEL), 1.0),
        "w_in": nrm(ks[1], (L, D_MODEL, IN_WIDTH), D_MODEL ** -0.5),
        "w_pool": nrm(ks[2], (L, len(POOL_WINDOWS), POOL_GROUP, POOL_GROUP), POOL_GROUP ** -0.5),
        "pool_scale": 1.0 + nrm(ks[3], (L, POOL_WIDTH), 0.02),
        "t5_bias": nrm(ks[4], (N_BUCKETS, DIL_HEADS), 0.2),
        "conv_w": nrm(ks[5], (L, CONV_TAPS, CONV_WIDTH), CONV_TAPS ** -0.5),
        "q_norm_g": 1.0 + nrm(ks[6], (L, MLA_Q_RANK), 0.02),
        "w_uq": nrm(ks[7], (L, MLA_Q_RANK, MLA_HEADS * (MLA_NOPE_DIM + MLA_ROPE_DIM)), MLA_Q_RANK ** -0.5),
        "kv_norm_g": 1.0 + nrm(ks[8], (L, MLA_KV_RANK), 0.02),
        "w_ukv": nrm(ks[9], (L, MLA_KV_RANK, MLA_HEADS * (MLA_NOPE_DIM + MLA_V_DIM)), MLA_KV_RANK ** -0.5),
        "w_out": nrm(ks[10], (L, MIX_WIDTH, D_MODEL), DEEPNORM_BETA * MIX_WIDTH ** -0.5),
        "ln1_g": 1.0 + nrm(ks[11], (L, D_MODEL), 0.02),
        "ln1_b": nrm(ks[12], (L, D_MODEL), 0.02),
        "w_gate": nrm(ks[13], (L, D_MODEL, FFN_HIDDEN), D_MODEL ** -0.5),
        "w_up": nrm(ks[14], (L, D_MODEL, FFN_HIDDEN), D_MODEL ** -0.5),
        "w_down": nrm(ks[15], (L, FFN_HIDDEN, D_MODEL), DEEPNORM_BETA * FFN_HIDDEN ** -0.5),
        "ln2_g": 1.0 + nrm(ks[16], (L, D_MODEL), 0.02),
        "ln2_b": nrm(ks[17], (L, D_MODEL), 0.02),
    }


def reference(x, w_in, w_pool, pool_scale, t5_bias, conv_w, q_norm_g, w_uq, kv_norm_g, w_ukv,
              w_out, ln1_g, ln1_b, w_gate, w_up, w_down, ln2_g, ln2_b):
    b, s, _ = x.shape
    split_points = [int(i) for i in np.cumsum(IN_SIZES)[:-1]]
    for l in range(DEPTH):
        proj = x @ w_in[l]
        u, q, k, v, hc, bg, cg, cq, ckv, kr = jnp.split(proj, split_points, axis=-1)
        y_a = pool_mixer(u, w_pool[l], pool_scale[l])
        heads = lambda t: t.reshape(b, s, DIL_HEADS, DIL_HEAD_DIM)
        y_b = dilated_attention(heads(q), heads(k), heads(v), t5_bias).reshape(b, s, DIL_WIDTH)
        y_c = short_conv(hc, bg, cg, conv_w[l])
        y_d = mla(cq, ckv, kr, q_norm_g[l], w_uq[l], kv_norm_g[l], w_ukv[l])
        mixed = jnp.concatenate([y_a, y_b, y_c, y_d], axis=-1) @ w_out[l]
        x = _layernorm(DEEPNORM_ALPHA * x + mixed, ln1_g[l], ln1_b[l])
        hid = jax.nn.silu(x @ w_gate[l]) * (x @ w_up[l])
        x = _layernorm(DEEPNORM_ALPHA * x + hid @ w_down[l], ln2_g[l], ln2_b[l])
    return x
```

```cpp
#include <hip/hip_runtime.h>
#include <cstdio>
#include <cstdint>
#include <cmath>
namespace pg8 {
#define PG8_LAS __attribute__((address_space(3)))
typedef unsigned short bf16_t;
typedef short bf16x8 __attribute__((ext_vector_type(8)));
typedef float f32x4 __attribute__((ext_vector_type(4)));
typedef unsigned u32x4 __attribute__((ext_vector_type(4)));
constexpr int BM = 256, BK = 64, HALF = 128, HTB = HALF * BK * 2  , STAGE_BYTES = 8 * HTB, NXCD = 8, WGM = 8;

__host__ __device__ __forceinline__ int lds_byte(int r, int c) { const int st = (r >> 4) * 2 + (c >> 5), rr = r & 15, cc = c & 31, ob = rr * 64 + cc * 2; return st * 1024 + (ob ^ (((ob >> 9) & 1) << 5)); }
__host__ __device__ __forceinline__ void stage_rc(int b, int& R, int& C) { const int st = b / 1024, sb = b % 1024, swz = sb ^ (((sb >> 9) & 1) << 5); R = (st >> 1) * 16 + swz / 64; C = (st & 1) * 32 + (swz % 64) / 2; }
__host__ __device__ __forceinline__ int perm32(int rho) { const int n = rho >> 4, i = rho & 15; return 8 * (i >> 2) + 4 * n + (i & 3); }

struct Unit { int pm, pn; };
struct Gemm { const bf16_t* A; const bf16_t* Bt; int M, N, K, lda, ldb, acs; };

struct StaticOrder {
    int nM, nN, nwg, G, c;
    __host__ __device__ void init(int M, int N, int G_, int c_) { nM = M / BM; nN = N / BM; nwg = nM * nN; G = G_; c = c_; }
    __host__ __device__ bool next(int i, Unit& u) const {
        const long L = (long)i * G + c; if (L >= nwg) return false;
        int wgid = (int)L; { const int q = nwg / NXCD, r = nwg % NXCD, xcd = wgid % NXCD, off = wgid / NXCD; wgid = (xcd < r ? xcd * (q + 1) : r * (q + 1) + (xcd - r) * q) + off; }
        const int nig = WGM * nN, gid = wgid / nig, fm = gid * WGM, gsz = (nM - fm) < WGM ? (nM - fm) : WGM;
        u.pm = fm + ((wgid % nig) % gsz); u.pn = (wgid % nig) / gsz; return true;
    }
    __device__ __forceinline__ void a_ready(const Unit&) const {}
    __device__ __forceinline__ void done(const Unit&) const {}
};

__device__ __forceinline__ unsigned cvt_pk_bf16(float lo, float hi) { unsigned r; asm volatile("v_cvt_pk_bf16_f32 %0, %1, %2" : "=v"(r) : "v"(lo), "v"(hi)); return r; }

struct EpiBf16 {
    static constexpr bool PERM = true;
    bf16_t* O; int ldc; const float* rs;
    __device__ __forceinline__ void operator()(const f32x4 (&acc)[2][2][4][2], const Unit& u, int wr, int wc, int fr, int fq) const {
        const int row0 = u.pm * BM + wr * 64 + fr, col0 = u.pn * BM + wc * 32 + 8 * fq;
#pragma unroll
        for (int ai = 0; ai < 2; ++ai)
#pragma unroll
            for (int m = 0; m < 4; ++m) { const int row = row0 + ai * HALF + m * 16; const float s = rs ? rs[row] : 1.f; bf16_t* rowp = O + (size_t)row * ldc + col0;
#pragma unroll
                for (int bj = 0; bj < 2; ++bj) { const f32x4 v0 = acc[ai][bj][m][0] * s, v1 = acc[ai][bj][m][1] * s;
                    u32x4 w; w.x = cvt_pk_bf16(v0[0], v0[1]); w.y = cvt_pk_bf16(v0[2], v0[3]); w.z = cvt_pk_bf16(v1[0], v1[1]); w.w = cvt_pk_bf16(v1[2], v1[3]);
                    *(u32x4*)(rowp + bj * HALF) = w; } }
    }
};
struct EpiQRope {
    static constexpr bool PERM = true;
    bf16_t* Q; const float* rq; const float* cs; const float* sn; float qs;
    __device__ __forceinline__ void operator()(const f32x4 (&acc)[2][2][4][2], const Unit& u, int wr, int wc, int fr, int fq) const {
        const int row0 = u.pm * BM + wr * 64 + fr, col0 = u.pn * BM + wc * 32 + 8 * fq;
        int j0[2]; bool rope[2];
#pragma unroll
        for (int bj = 0; bj < 2; ++bj) { const int c0 = col0 + bj * HALF, h = c0 / 192, w = c0 - h * 192; rope[bj] = (w >= 128); j0[bj] = rope[bj] ? ((w - 128) >> 1) : 0; }
#pragma unroll
        for (int ai = 0; ai < 2; ++ai)
#pragma unroll
            for (int m = 0; m < 4; ++m) { const int row = row0 + ai * HALF + m * 16; const float s = rq[row] * qs; bf16_t* rowp = Q + (size_t)row * 1536 + col0;
#pragma unroll
                for (int bj = 0; bj < 2; ++bj) { f32x4 v0 = acc[ai][bj][m][0] * s, v1 = acc[ai][bj][m][1] * s;
                    if (rope[bj]) { const f32x4 c = *(const f32x4*)(cs + (size_t)row * 32 + j0[bj]), sv = *(const f32x4*)(sn + (size_t)row * 32 + j0[bj]);
                        const f32x4 a0 = v0, a1 = v1;
                        v0[0] = a0[0] * c[0] - a0[1] * sv[0]; v0[1] = a0[0] * sv[0] + a0[1] * c[0];
                        v0[2] = a0[2] * c[1] - a0[3] * sv[1]; v0[3] = a0[2] * sv[1] + a0[3] * c[1];
                        v1[0] = a1[0] * c[2] - a1[1] * sv[2]; v1[1] = a1[0] * sv[2] + a1[1] * c[2];
                        v1[2] = a1[2] * c[3] - a1[3] * sv[3]; v1[3] = a1[2] * sv[3] + a1[3] * c[3]; }
                    u32x4 w; w.x = cvt_pk_bf16(v0[0], v0[1]); w.y = cvt_pk_bf16(v0[2], v0[3]); w.z = cvt_pk_bf16(v1[0], v1[1]); w.w = cvt_pk_bf16(v1[2], v1[3]);
                    *(u32x4*)(rowp + bj * HALF) = w; } }
    }
};
struct EpiBf16ColScale {
    static constexpr bool PERM = true;
    bf16_t* O; int ldc; const float* csc;
    __device__ __forceinline__ void operator()(const f32x4 (&acc)[2][2][4][2], const Unit& u, int wr, int wc, int fr, int fq) const {
        const int row0 = u.pm * BM + wr * 64 + fr, col0 = u.pn * BM + wc * 32 + 8 * fq;
        f32x4 sc[2][2];
#pragma unroll
        for (int bj = 0; bj < 2; ++bj)
#pragma unroll
            for (int n = 0; n < 2; ++n) sc[bj][n] = *(const f32x4*)(csc + col0 + bj * HALF + 4 * n);
#pragma unroll
        for (int ai = 0; ai < 2; ++ai)
#pragma unroll
            for (int m = 0; m < 4; ++m) { const int row = row0 + ai * HALF + m * 16; bf16_t* rowp = O + (size_t)row * ldc + col0;
#pragma unroll
                for (int bj = 0; bj < 2; ++bj) { const f32x4 v0 = acc[ai][bj][m][0] * sc[bj][0], v1 = acc[ai][bj][m][1] * sc[bj][1];
                    u32x4 w; w.x = cvt_pk_bf16(v0[0], v0[1]); w.y = cvt_pk_bf16(v0[2], v0[3]); w.z = cvt_pk_bf16(v1[0], v1[1]); w.w = cvt_pk_bf16(v1[2], v1[3]);
                    *(u32x4*)(rowp + bj * HALF) = w; } }
    }
};
struct EpiResF32 {
    static constexpr bool PERM = false;
    const float* res; float* Y; int ldc; float alpha;
    __device__ __forceinline__ void operator()(const f32x4 (&acc)[2][2][4][2], const Unit& u, int wr, int wc, int fr, int fq) const {
        const int row0 = u.pm * BM + wr * 64 + fr, col0 = u.pn * BM + wc * 32 + 4 * fq;
#pragma unroll
        for (int ai = 0; ai < 2; ++ai)
#pragma unroll
            for (int m = 0; m < 4; ++m) { const size_t off = (size_t)(row0 + ai * HALF + m * 16) * ldc + col0;
#pragma unroll
                for (int bj = 0; bj < 2; ++bj)
#pragma unroll
                    for (int n = 0; n < 2; ++n) { const size_t p = off + bj * HALF + n * 16; const f32x4 r = *(const f32x4*)(res + p); *(f32x4*)(Y + p) = r * alpha + acc[ai][bj][m][n]; } }
    }
};
struct EpiSwiGLU {
    static constexpr bool PERM = true;
    bf16_t* H; int ldc;
    __device__ __forceinline__ float sg(float g, float u) const { return g * u * __builtin_amdgcn_rcpf(1.0f + __builtin_amdgcn_exp2f(-1.4426950408889634f * g)); }
    __device__ __forceinline__ void operator()(const f32x4 (&acc)[2][2][4][2], const Unit& u, int wr, int wc, int fr, int fq) const {
        const int row0 = u.pm * BM + wr * 64 + fr, col0 = u.pn * HALF + wc * 32 + 8 * fq;
#pragma unroll
        for (int ai = 0; ai < 2; ++ai)
#pragma unroll
            for (int m = 0; m < 4; ++m) { bf16_t* rowp = H + (size_t)(row0 + ai * HALF + m * 16) * ldc + col0;
                const f32x4 g0 = acc[ai][0][m][0], g1 = acc[ai][0][m][1], u0 = acc[ai][1][m][0], u1 = acc[ai][1][m][1];
                u32x4 w; w.x = cvt_pk_bf16(sg(g0[0], u0[0]), sg(g0[1], u0[1])); w.y = cvt_pk_bf16(sg(g0[2], u0[2]), sg(g0[3], u0[3]));
                w.z = cvt_pk_bf16(sg(g1[0], u1[0]), sg(g1[1], u1[1])); w.w = cvt_pk_bf16(sg(g1[2], u1[2]), sg(g1[3], u1[3]));
                *(u32x4*)rowp = w; }
    }
};

template <class Epi, class Sched, bool ALIGN_EPI = true>
__device__ __forceinline__ void gemm_phase(PG8_LAS unsigned char* lds, const Gemm g, const Sched& S, const Epi& E) {
    int tid_ = threadIdx.x; asm volatile("" : "+v"(tid_));
    const int tid = tid_, wid = __builtin_amdgcn_readfirstlane(tid >> 6), lane = tid & 63, wr = wid >> 2, wc = wid & 3, fr = lane & 15, fq = lane >> 4;
    const int K = g.K, nt = K / BK;
    unsigned voffA[2], voffB[2];
#pragma unroll
    for (int i = 0; i < 2; ++i) { int R, C; stage_rc(tid * 16 + i * 8192, R, C); const int Rb = Epi::PERM ? ((R & ~31) + perm32(R & 31)) : R;
        voffA[i] = (unsigned)(R * g.lda + C) * 2u; voffB[i] = (unsigned)(Rb * (g.ldb ? g.ldb : BK) + C) * 2u; }
    const size_t kstep = (size_t)(BK * 2), kstepB = g.ldb ? kstep : (size_t)BM * BK * 2;
    const size_t hstepA = (size_t)HALF * g.lda * 2, hstepB = g.ldb ? (size_t)HALF * g.ldb * 2 : (size_t)HALF * BK * 2;
    const size_t tstepA = 2 * hstepA, tstepB = g.ldb ? 2 * hstepB : (size_t)(K / BK) * BM * BK * 2;
    const unsigned ldsw = (unsigned)wid * 1024u;
    const int aoff = lds_byte(wr * 64 + fr, fq * 8), boff = lds_byte(wc * 32 + fr, fq * 8);
#define PG8_SA(b, h) (((b) * 2 + (h)) * HTB)
#define PG8_SB(b, h) ((4 + (b) * 2 + (h)) * HTB)
#define PG8_STAGE(bufoff, gbase, voff) do { _Pragma("unroll") for (int _i = 0; _i < 2; ++_i) \
        __builtin_amdgcn_global_load_lds((const unsigned*)((const char*)(gbase) + (voff)[_i]), (PG8_LAS unsigned*)(lds + (bufoff) + ldsw + _i * 8192), 16, 0, 0); } while (0)
#define PG8_LDA(dst, b, h) do { _Pragma("unroll") for (int m = 0; m < 4; ++m) _Pragma("unroll") for (int k = 0; k < 2; ++k) dst[m][k] = *(const PG8_LAS bf16x8*)(lds + PG8_SA(b, h) + aoff + m * 2048 + k * 1024); } while (0)
#define PG8_LDB(dst, b, h) do { _Pragma("unroll") for (int n = 0; n < 2; ++n) _Pragma("unroll") for (int k = 0; k < 2; ++k) dst[n][k] = *(const PG8_LAS bf16x8*)(lds + PG8_SB(b, h) + boff + n * 2048 + k * 1024); } while (0)
#define PG8_MMA(ai, bj, At, Bt) do { __builtin_amdgcn_s_setprio(1); _Pragma("unroll") for (int m = 0; m < 4; ++m) _Pragma("unroll") for (int n = 0; n < 2; ++n) _Pragma("unroll") for (int k = 0; k < 2; ++k) \
        acc[ai][bj][m][n] = __builtin_amdgcn_mfma_f32_16x16x32_bf16(Bt[n][k], At[m][k], acc[ai][bj][m][n], 0, 0, 0); __builtin_amdgcn_s_setprio(0); } while (0)
#define PG8_WAIT_V(n) asm volatile("s_waitcnt vmcnt(" #n ")" ::: "memory")
#define PG8_WAIT_L(n) asm volatile("s_waitcnt lgkmcnt(" #n ")" ::: "memory")
#define PG8_BAR __builtin_amdgcn_s_barrier()
#define PG8_SCHED __builtin_amdgcn_sched_barrier(0)
    Unit cur, nxt; int ui = 0;
    if (!S.next(0, cur)) return;
    f32x4 acc[2][2][4][2];
#pragma unroll
    for (int a = 0; a < 2; ++a)
#pragma unroll
        for (int b = 0; b < 2; ++b)
#pragma unroll
            for (int m = 0; m < 4; ++m)
#pragma unroll
                for (int n = 0; n < 2; ++n) acc[a][b][m][n] = (f32x4){0.f, 0.f, 0.f, 0.f};
    bf16x8 At[4][2], B0[2][2], B1[2][2];
    const char* cA = (const char*)g.A + (size_t)cur.pm * tstepA + (size_t)cur.pn * g.acs; const char* cB = (const char*)g.Bt + (size_t)cur.pn * tstepB;
    S.a_ready(cur);
    PG8_STAGE(PG8_SB(0, 0), cB, voffB); PG8_STAGE(PG8_SB(0, 1), cB + hstepB, voffB); PG8_STAGE(PG8_SA(0, 0), cA, voffA); PG8_STAGE(PG8_SA(0, 1), cA + hstepA, voffA);
    if (wr == 1) PG8_BAR;
    PG8_WAIT_V(2); PG8_BAR;
    PG8_STAGE(PG8_SB(1, 0), cB + kstepB, voffB); PG8_STAGE(PG8_SA(1, 0), cA + kstep, voffA); PG8_STAGE(PG8_SB(1, 1), cB + hstepB + kstepB, voffB);
    PG8_WAIT_V(6); PG8_BAR;
    for (;;) {
        const bool has_next = S.next(ui + 1, nxt);
        const char* nA = has_next ? (const char*)g.A + (size_t)nxt.pm * tstepA + (size_t)nxt.pn * g.acs : cA; const char* nB = has_next ? (const char*)g.Bt + (size_t)nxt.pn * tstepB : cB;
        for (int t = 0; t < nt; t += 2) {
            asm volatile("" : "+v"(voffA[0]), "+v"(voffA[1]), "+v"(voffB[0]), "+v"(voffB[1]));
            const bool last = (t == nt - 2);
            const char* a1 = cA + (size_t)(t + 1) * kstep;
            const char* a2 = last ? nA : cA + (size_t)(t + 2) * kstep; const char* b2 = last ? nB : cB + (size_t)(t + 2) * kstepB;
            const char* a3 = a2 + kstep; const char* b3 = b2 + kstepB;
            if (last && has_next) S.a_ready(nxt);
            PG8_LDB(B0, 0, 0); PG8_LDB(B1, 0, 1); PG8_SCHED; PG8_LDA(At, 0, 0); PG8_STAGE(PG8_SA(1, 1), a1 + hstepA, voffA);
            PG8_WAIT_V(8); PG8_WAIT_L(0); PG8_BAR; PG8_MMA(0, 0, At, B0); PG8_MMA(0, 1, At, B1); PG8_BAR; PG8_SCHED;
            PG8_LDA(At, 0, 1); PG8_STAGE(PG8_SB(0, 0), b2, voffB); PG8_STAGE(PG8_SB(0, 1), b2 + hstepB, voffB); PG8_STAGE(PG8_SA(0, 0), a2, voffA);
            PG8_WAIT_V(8); PG8_WAIT_L(0); PG8_BAR; PG8_MMA(1, 0, At, B0); PG8_MMA(1, 1, At, B1); PG8_BAR; PG8_SCHED;
            PG8_LDB(B0, 1, 0); PG8_LDB(B1, 1, 1); PG8_SCHED; PG8_LDA(At, 1, 0); PG8_STAGE(PG8_SA(0, 1), a2 + hstepA, voffA);
            PG8_WAIT_V(8); PG8_WAIT_L(0); PG8_BAR; PG8_MMA(0, 0, At, B0); PG8_MMA(0, 1, At, B1); PG8_BAR; PG8_SCHED;
            PG8_LDA(At, 1, 1); PG8_STAGE(PG8_SB(1, 0), b3, voffB); PG8_STAGE(PG8_SB(1, 1), b3 + hstepB, voffB); PG8_STAGE(PG8_SA(1, 0), a3, voffA);
            PG8_WAIT_V(8); PG8_WAIT_L(0); PG8_BAR; PG8_MMA(1, 0, At, B0); PG8_MMA(1, 1, At, B1); PG8_BAR; PG8_SCHED;
        }
        if constexpr (ALIGN_EPI) { if (wr == 0) PG8_BAR; }
        E(acc, cur, wr, wc, fr, fq);
#ifdef MK_EPI_TWICE
        asm volatile("" ::: "memory"); E(acc, cur, wr, wc, fr, fq);
#endif
        S.done(cur);
        if (!has_next) break;
#pragma unroll
        for (int a = 0; a < 2; ++a)
#pragma unroll
            for (int b = 0; b < 2; ++b)
#pragma unroll
                for (int m = 0; m < 4; ++m)
#pragma unroll
                    for (int n = 0; n < 2; ++n) acc[a][b][m][n] = (f32x4){0.f, 0.f, 0.f, 0.f};
        cur = nxt; cA = nA; cB = nB; ++ui;
        if constexpr (ALIGN_EPI) { if (wr == 1) PG8_BAR; }
    }
    PG8_WAIT_V(0);
    if constexpr (!ALIGN_EPI) { if (wr == 0) PG8_BAR; }
    PG8_BAR;
#undef PG8_SA
#undef PG8_SB
#undef PG8_STAGE
#undef PG8_LDA
#undef PG8_LDB
#undef PG8_MMA
#undef PG8_WAIT_V
#undef PG8_WAIT_L
#undef PG8_BAR
#undef PG8_SCHED
}
}
constexpr bool XL_LN1 = false, XL_LN2 = false;
constexpr int NWAVES = 8;
#ifndef MK_ONE_LAUNCH
#define MK_ONE_LAUNCH 1
#endif
#ifndef MLA_UNIT
#define MLA_UNIT unit
#endif
#ifndef MK_MLA_CONV
#define MK_MLA_CONV 1
#endif
#ifndef MK_NAIVE_MLA
#define MK_NAIVE_MLA 0
#endif
#ifndef MK_NAIVE_DIL
#define MK_NAIVE_DIL 0
#endif

constexpr int SEQ = 16384, DM = 4096, DEPTH = 4, M = SEQ;
constexpr int INW = 8512, INWP = 8704, FFN = 11008;
constexpr int C_U = 0, C_Q = 1024, C_K = 2048, C_V = 3072, C_H = 4096, C_B = 5120, C_C = 6144, C_CQ = 7168, C_CKV = 7936, C_KR = 8448;
constexpr int QRANK = 768, KVRANK = 512, NHEAD = 8;
constexpr float LN_EPS = 1e-5f, RMS_EPS = 1e-6f;
constexpr float ALPHA = 1.681792830507429f;
constexpr float QSCALE = 0.07216878364870322f * 1.4426950408889634f;
constexpr float DIL_SCALE = 0.08838834764831845f;
constexpr int NPH = 9, NPHASES = 1 + DEPTH * NPH;

constexpr size_t MiB = 1u << 20;
constexpr size_t WS_CTL = 0, CTL_ZERO_BYTES = 1 * MiB;
constexpr size_t WS_BIAS = 1 * MiB, WS_RQ = 1 * MiB + 65536, WS_RKV = 1 * MiB + 2 * 65536;
constexpr size_t WS_COS = 2 * MiB, WS_SIN = 4 * MiB, WS_KR = 6 * MiB;
constexpr size_t WS_W = 8 * MiB, W_LAYER = 363 * MiB;
constexpr size_t W_IN = 0, W_OUT = 68 * MiB, W_GU = 100 * MiB, W_DN = 272 * MiB, W_UQ = 358 * MiB, W_UK = 360 * MiB + 512 * 1024, W_UV = 361 * MiB + 512 * 1024, W_POOL = 362 * MiB + 512 * 1024;
constexpr size_t WS_XB = WS_W + DEPTH * W_LAYER;
constexpr size_t WS_PROJ = WS_XB + 128 * MiB;
constexpr size_t WS_MIX = WS_PROJ + 272 * MiB;
constexpr size_t WS_HID = WS_PROJ;
constexpr size_t WS_PD = WS_MIX + 128 * MiB;
constexpr size_t WS_Q = WS_PD + 32 * MiB;
constexpr size_t WS_KN = WS_Q + 48 * MiB;
constexpr size_t WS_VT = WS_KN + 32 * MiB;
constexpr size_t WS_DSO = WS_VT + 32 * MiB;
constexpr size_t WS_DSML = WS_DSO + 64 * MiB;
constexpr size_t WS_XL = WS_DSML + 1 * MiB;
constexpr size_t WS_END = WS_XL + 128 * MiB;
constexpr size_t WS_YB = WS_PD;
static_assert(WS_YB + 128 * MiB <= WS_DSO, "YB overlay");
static_assert((size_t)M * FFN * 2 <= 400 * MiB && (size_t)INWP * DM * 2 == 68 * MiB && (size_t)2 * FFN * DM * 2 == 172 * MiB && (size_t)DM * FFN * 2 == 86 * MiB, "d_ws map");
constexpr int CW_TMO = 0, CW_CODE = 1;
constexpr int CW_BAR = 4096;

constexpr int RING_OFF = 0, RING_BYTES = 131072;
constexpr int LDSCTL_OFF = RING_BYTES, MISC_OFF = LDSCTL_OFF + 320;
constexpr int BGSLOT_HI = LDSCTL_OFF + 1024;
constexpr int LDS_BYTES = 153600;
static_assert(MISC_OFF + 128 <= BGSLOT_HI && BGSLOT_HI + 5 * 4224 <= LDS_BYTES, "LDS map");

#define GAS __attribute__((address_space(1)))
#define LAS __attribute__((address_space(3)))
typedef unsigned short bf16;
typedef unsigned v4u __attribute__((ext_vector_type(4)));
typedef float f32x4 __attribute__((ext_vector_type(4)));
typedef GAS unsigned gu32;
#define RLX_AGENT __ATOMIC_RELAXED, __HIP_MEMORY_SCOPE_AGENT
#define LDS_WAIT() asm volatile("s_waitcnt lgkmcnt(0)" ::: "memory")
#define VM_WAIT() asm volatile("s_waitcnt vmcnt(0)" ::: "memory")
__device__ __forceinline__ unsigned f2bf(float f) { unsigned u = __builtin_bit_cast(unsigned, f); return (u + 0x7fffu + ((u >> 16) & 1u)) >> 16; }
__device__ __forceinline__ unsigned pk2(float lo, float hi) { return f2bf(lo) | (f2bf(hi) << 16); }
__device__ __forceinline__ float bflo(unsigned w) { return __builtin_bit_cast(float, w << 16); }
__device__ __forceinline__ float bfhi(unsigned w) { return __builtin_bit_cast(float, w & 0xffff0000u); }
__device__ __forceinline__ float bf2f(bf16 b) { return __builtin_bit_cast(float, (unsigned)b << 16); }

#define XB_TMO      128
#define XB_XCNT(j)  (256  + 64 * (j))
#define XB_XSUB(j)  (1280 + 64 * (j))
#define XB_XGEN(j)  (2304 + 64 * (j))
#define XB_TOP      3328
#define XB_TOPGEN   3392
#define XCD_BAR_WORDS 3456
#define XB_SPIN_CAP (1u << 22)

__device__ __forceinline__ unsigned xb_ld(unsigned* p)              { return __hip_atomic_load(p, __ATOMIC_RELAXED, __HIP_MEMORY_SCOPE_AGENT); }
__device__ __forceinline__ unsigned xb_add(unsigned* p, unsigned v) { return __hip_atomic_fetch_add(p, v, __ATOMIC_RELAXED, __HIP_MEMORY_SCOPE_AGENT); }
__device__ __forceinline__ unsigned xb_xcc_id() { return (unsigned)__builtin_amdgcn_s_getreg((3 << 11) | 20) & 0xFu; }
#define XB_SPIN(cond, bar) do { unsigned _sp = 0; while (cond) { __builtin_amdgcn_s_sleep(1); \
    if ((++_sp & 255u) == 0u) { if (xb_ld(&(bar)[XB_TMO])) break; if (_sp > XB_SPIN_CAP) { atomicAdd(&(bar)[XB_TMO], 1u); break; } } } } while (0)

struct XcdBarrier {
    unsigned* bar; unsigned x;
    volatile LAS unsigned* st;
};
__device__ __forceinline__ XcdBarrier xcd_barrier_post(unsigned* bar, volatile LAS unsigned* st) {
    XcdBarrier b; b.bar = bar; b.x = xb_xcc_id(); b.st = st;
    if (threadIdx.x == 0) (void)xb_add(&bar[XB_XCNT(b.x)], 1u);
    return b;
}
__device__ __forceinline__ void xcd_barrier_complete(unsigned* bar, unsigned x, unsigned& nloc, unsigned& nx) {
    const unsigned G = gridDim.x * gridDim.y * gridDim.z;
    unsigned sum, cnt, mine, sp = 0u;
    for (;;) {
        sum = 0u; cnt = 0u; mine = 0u;
#pragma unroll
        for (unsigned j = 0; j < 16; ++j) { const unsigned c = xb_ld(&bar[XB_XCNT(j)]); sum += c; cnt += (c > 0u) ? 1u : 0u; mine = (j == x) ? c : mine; }
        if (sum == G) break;
        __builtin_amdgcn_s_sleep(1);
        if ((++sp & 255u) == 0u) { if (xb_ld(&bar[XB_TMO])) break; if (sp > XB_SPIN_CAP) { atomicAdd(&bar[XB_TMO], 1u); break; } }
    }
    nloc = mine > 0u ? mine : 1u; nx = cnt > 0u ? cnt : 1u;
}
__device__ __forceinline__ void xcd_barrier(const XcdBarrier& b) {
    asm volatile("s_waitcnt vmcnt(0)" ::: "memory");
    __syncthreads();
    if (threadIdx.x == 0) {
        unsigned* bar = b.bar;
        __builtin_amdgcn_s_waitcnt(0);
        unsigned nloc = b.st[0], nx = b.st[1];
        if (nloc == 0u) { xcd_barrier_complete(bar, b.x, nloc, nx); b.st[0] = nloc; b.st[1] = nx; }
        const unsigned old = xb_add(&bar[XB_XSUB(b.x)], 1u);
        const unsigned gen = old / nloc;
        if (old + 1u == (gen + 1u) * nloc) {
            __builtin_amdgcn_fence(__ATOMIC_RELEASE, "agent");
            asm volatile("s_waitcnt vmcnt(0)" ::: "memory");
            const unsigned og = xb_add(&bar[XB_TOP], 1u);
            const unsigned tg = og / nx;
            if (og + 1u == (tg + 1u) * nx) xb_add(&bar[XB_TOPGEN], 1u);
            else XB_SPIN(xb_ld(&bar[XB_TOPGEN]) == tg, bar);
            __builtin_amdgcn_fence(__ATOMIC_ACQUIRE, "agent");
            xb_add(&bar[XB_XGEN(b.x)], 1u);
            asm volatile("s_waitcnt vmcnt(0)" ::: "memory");
        } else {
            XB_SPIN(xb_ld(&bar[XB_XGEN(b.x)]) == gen, bar);
            __builtin_amdgcn_fence(__ATOMIC_ACQUIRE, "agent");
            asm volatile("s_waitcnt vmcnt(0)" ::: "memory");
        }
    }
    __syncthreads();
}

__device__ __forceinline__ float wave_sum(float v) {
#pragma unroll
    for (int o = 1; o < 64; o <<= 1) v += __shfl_xor(v, o);
    return v;
}
__device__ __forceinline__ float wave_max(float v) {
#pragma unroll
    for (int o = 1; o < 64; o <<= 1) v = fmaxf(v, __shfl_xor(v, o));
    return v;
}
__device__ const unsigned char T5_BUCKET[3 * 129] = {
0,1,2,3,4,5,6,7,8,9,10,11,12,13,14,15,16,16,16,16,16,16,17,17,17,17,17,17,17,17,18,18,18,18,18,18,18,18,18,18,19,19,19,19,19,19,19,19,19,19,19,19,19,19,20,20,20,20,20,20,20,20,20,20,20,20,20,20,20,20,20,20,20,21,21,21,21,21,21,21,21,21,21,21,21,21,21,21,21,21,21,21,21,21,21,21,21,21,21,22,22,22,22,22,22,22,22,22,22,22,22,22,22,22,22,22,22,22,22,22,22,22,22,22,22,22,22,22,22,
0,4,8,12,16,16,17,17,18,18,19,19,19,19,20,20,20,20,20,21,21,21,21,21,21,22,22,22,22,22,22,22,22,22,23,23,23,23,23,23,23,23,23,23,23,23,24,24,24,24,24,24,24,24,24,24,24,24,24,24,24,24,25,25,25,25,25,25,25,25,25,25,25,25,25,25,25,25,25,25,25,25,25,26,26,26,26,26,26,26,26,26,26,26,26,26,26,26,26,26,26,26,26,26,26,26,26,26,26,26,26,26,26,27,27,27,27,27,27,27,27,27,27,27,27,27,27,27,27,
0,16,18,19,20,21,21,22,22,23,23,23,24,24,24,24,25,25,25,25,25,26,26,26,26,26,26,26,26,27,27,27,27,27,27,27,27,27,27,28,28,28,28,28,28,28,28,28,28,28,28,28,29,29,29,29,29,29,29,29,29,29,29,29,29,29,29,29,29,29,30,30,30,30,30,30,30,30,30,30,30,30,30,30,30,30,30,30,30,30,30,30,30,30,30,31,31,31,31,31,31,31,31,31,31,31,31,31,31,31,31,31,31,31,31,31,31,31,31,31,31,31,31,31,31,31,31,31,31};

__device__ __forceinline__ size_t wt_off(int r, int k, int ldt, int nkt) { return nkt ? ((size_t)((r >> 8) * nkt + (k >> 6)) * 256 + (r & 255)) * 64 + (k & 63) : (size_t)r * ldt + k; }
__device__ __forceinline__ void tr_item(const float* W, int N, int k0, int ns0, bf16* WT, int ldt, int orow0, int ostride, const float* gk, const float* gn, LAS float* scr, int lane, int nkt) {
    const float gnv = gn ? gn[ns0 + (lane & 31)] : 1.f;
#pragma unroll 8
    for (int i = 0; i < 32; ++i) { const int kk = 2 * i + (lane >> 5); float v = W[(size_t)(k0 + kk) * N + ns0 + (lane & 31)] * gnv; if (gk) v *= gk[k0 + kk]; scr[kk * 33 + (lane & 31)] = v; }
    LDS_WAIT(); asm volatile("" ::: "memory");
    const int c = lane & 7;
#pragma unroll
    for (int j = 0; j < 4; ++j) { const int n = (lane >> 3) + 8 * j; const LAS float* s = scr + (8 * c) * 33 + n;
        v4u o; o.x = pk2(s[0 * 33], s[1 * 33]); o.y = pk2(s[2 * 33], s[3 * 33]); o.z = pk2(s[4 * 33], s[5 * 33]); o.w = pk2(s[6 * 33], s[7 * 33]);
        *(v4u*)(WT + wt_off(orow0 + ostride * n, k0 + 8 * c, ldt, nkt)) = o; }
    LDS_WAIT(); asm volatile("" ::: "memory");
}
__device__ __forceinline__ void sincos_acc(float angf, float& sn, float& cs) {
    const double x = (double)angf;
    const double q = __builtin_rint(x * 0.63661977236758134308);
    double y = __builtin_fma(-q, 1.57079632679489655800, x); y = __builtin_fma(-q, 6.12323399573676603587e-17, y);
    const double y2 = y * y;
    double s = -7.647163731819816e-13;
    s = s * y2 + 1.6059043836821613e-10; s = s * y2 - 2.505210838544172e-08; s = s * y2 + 2.7557319223985893e-06; s = s * y2 - 1.984126984126984e-04; s = s * y2 + 8.333333333333333e-03; s = s * y2 - 1.6666666666666666e-01; s = y + y * y2 * s;
    double c = -1.1470745597729725e-11;
    c = c * y2 + 2.08767569878681e-09; c = c * y2 - 2.755731922398589e-07; c = c * y2 + 2.48015873015873e-05; c = c * y2 - 1.388888888888889e-03; c = c * y2 + 4.1666666666666664e-02; c = c * y2 - 0.5; c = c * y2 + 1.0;
    const long long qi = (long long)q; const int k = (int)(qi & 3);
    const double ss = (k == 0) ? s : (k == 1) ? c : (k == 2) ? -s : -c;
    const double cc = (k == 0) ? c : (k == 1) ? -s : (k == 2) ? -c : s;
    sn = (float)ss; cs = (float)cc;
}
namespace mla {
typedef float f32x16 __attribute__((ext_vector_type(16)));
typedef short bf16x8 __attribute__((ext_vector_type(8)));
typedef unsigned u32x4 __attribute__((ext_vector_type(4)));
typedef unsigned u32x2 __attribute__((ext_vector_type(2)));
constexpr int KN_ROW = 272, KR_ROW = 144, VT_ROW = 144;
constexpr int KN_BYTES = 64 * KN_ROW, KR_BYTES = 64 * KR_ROW, VT_BYTES = 128 * VT_ROW;
constexpr int KN_OFF = 0, KR_OFF = KN_BYTES, VT_OFF = KN_BYTES + KR_BYTES, BUF_BYTES = KN_BYTES + KR_BYTES + VT_BYTES;
constexpr int NP_KN = KN_BYTES / 1024, NP_KR = KR_BYTES / 1024, NP_VT = VT_BYTES / 1024, NPIECE = NP_KN + NP_KR + NP_VT;
static_assert(NP_KN * 1024 == KN_BYTES && NP_KR * 1024 == KR_BYTES && NP_VT * 1024 == VT_BYTES && 2 * BUF_BYTES + 8 * 4096 <= 131072, "mla LDS map");
__device__ __forceinline__ int swap23(int x) { return (x & ~12) | ((x & 4) << 1) | ((x & 8) >> 1); }
__device__ __forceinline__ unsigned cvtpk(float lo, float hi) { unsigned r; asm volatile("v_cvt_pk_bf16_f32 %0, %1, %2" : "=v"(r) : "v"(lo), "v"(hi)); return r; }
__device__ __forceinline__ float xmax32(float v) { auto rr = __builtin_amdgcn_permlane32_swap(__float_as_uint(v), __float_as_uint(v), false, false); const unsigned r0 = rr[0], r1 = rr[1];
    return fmaxf(__uint_as_float(r0), __uint_as_float(r1)); }
__device__ __forceinline__ float xsum32(float v) { auto rr = __builtin_amdgcn_permlane32_swap(__float_as_uint(v), __float_as_uint(v), false, false); const unsigned r0 = rr[0], r1 = rr[1];
    return __uint_as_float(r0) + __uint_as_float(r1); }

__device__ __forceinline__ unsigned piece_voff(int P, int lane) {
    if (P < NP_KN) { const int s = 64 * P + lane, rho = s / 17; int ch = s - rho * 17; if (ch == 16) ch = 0; const int keyl = (rho & 32) | swap23(rho & 31); return (unsigned)(keyl * 2048 + ch * 16); }
    if (P < NP_KN + NP_KR) { const int s = 64 * (P - NP_KN) + lane, rho = s / 9; int ch = s - rho * 9; if (ch == 8) ch = 0; const int keyl = (rho & 32) | swap23(rho & 31); return (unsigned)(keyl * 128 + ch * 16); }
    { const int s = 64 * (P - NP_KN - NP_KR) + lane, row = s / 9; int ch = s - row * 9; if (ch == 8) ch = 0; return (unsigned)(row * (M * 2) + ch * 16); }
}

struct NoBg { int nfly; __device__ __forceinline__ void pre(int) {} __device__ __forceinline__ void post(int) {} };
template <class BG>
__device__ __forceinline__ void unit(LAS unsigned char* lds, const bf16* Q, const bf16* KN, const bf16* KR, const bf16* VT, bf16* MIX, int h, int qb, BG& bg) {
    int tid_ = threadIdx.x; asm volatile("" : "+v"(tid_));
    const int lane = tid_ & 63, wave = __builtin_amdgcn_readfirstlane(tid_ >> 6), c = lane & 31, hi = lane >> 5;
    const int q0 = qb * 256 + wave * 32, ntile = 4 * (qb + 1);
    unsigned voff[6];
#pragma unroll
    for (int k = 0; k < 6; ++k) voff[k] = piece_voff((wave + 8 * k) < NPIECE ? (wave + 8 * k) : 0, lane);
    const char* knb = (const char*)KN + (size_t)h * 256; const char* krb = (const char*)KR; const char* vtb = (const char*)VT + (size_t)h * 128 * (M * 2);
#define MLA_ISSUE(j, bufb) do { const size_t key0_ = (size_t)(j) * 64; \
        _Pragma("unroll") for (int k = 0; k < 6; ++k) { const int P = wave + 8 * k; if (P < NPIECE) { \
            const char* gb = (P < NP_KN) ? knb + key0_ * 2048 : (P < NP_KN + NP_KR) ? krb + key0_ * 128 : vtb + key0_ * 2; \
            __builtin_amdgcn_global_load_lds((const unsigned*)(gb + voff[k]), (LAS unsigned*)(lds + (bufb) + P * 1024), 16, 0, 0); } } } while (0)
    bf16x8 qf[12];
    { const bf16* qrow = Q + (size_t)(q0 + c) * 1536 + h * 192 + 8 * hi;
#pragma unroll
      for (int ch = 0; ch < 12; ++ch) qf[ch] = *(const bf16x8*)(qrow + 16 * ch); }
    MLA_ISSUE(0, 0);
    f32x16 O[4];
#pragma unroll
    for (int d = 0; d < 4; ++d)
#pragma unroll
        for (int r = 0; r < 16; ++r) O[d][r] = 0.f;
    float m = -1e30f, l = 0.f;
    const int kn_l = c * KN_ROW + hi * 16, kr_l = c * KR_ROW + hi * 16, vt_l = c * VT_ROW + hi * 16;
    asm volatile("s_waitcnt vmcnt(0)" ::: "memory"); __syncthreads();
    for (int j = 0; j < ntile; ++j) {
        const int bufb = (j & 1) * BUF_BYTES;
        bg.pre(j);
#ifndef MLA_SERIAL
        if (j + 1 < ntile) MLA_ISSUE(j + 1, BUF_BYTES - bufb);
#endif
        bg.post(j);
        const int key0 = j * 64;
        if (key0 <= q0 + 31) {
            const LAS unsigned char* kb = lds + bufb;
            f32x16 S0, S1;
#pragma unroll
            for (int r = 0; r < 16; ++r) { S0[r] = 0.f; S1[r] = 0.f; }
#pragma unroll
            for (int ch = 0; ch < 8; ++ch) {
                const bf16x8 a0 = *(const LAS bf16x8*)(kb + KN_OFF + kn_l + ch * 32), a1 = *(const LAS bf16x8*)(kb + KN_OFF + 32 * KN_ROW + kn_l + ch * 32);
                S0 = __builtin_amdgcn_mfma_f32_32x32x16_bf16(a0, qf[ch], S0, 0, 0, 0); S1 = __builtin_amdgcn_mfma_f32_32x32x16_bf16(a1, qf[ch], S1, 0, 0, 0); }
#pragma unroll
            for (int ch = 0; ch < 4; ++ch) {
                const bf16x8 a0 = *(const LAS bf16x8*)(kb + KR_OFF + kr_l + ch * 32), a1 = *(const LAS bf16x8*)(kb + KR_OFF + 32 * KR_ROW + kr_l + ch * 32);
                S0 = __builtin_amdgcn_mfma_f32_32x32x16_bf16(a0, qf[8 + ch], S0, 0, 0, 0); S1 = __builtin_amdgcn_mfma_f32_32x32x16_bf16(a1, qf[8 + ch], S1, 0, 0, 0); }
            if (key0 + 63 > q0) {
                const int lim = q0 + c - key0 - 8 * hi;
#pragma unroll
                for (int r = 0; r < 16; ++r) { const int ko = 16 * (r >> 3) + (r & 7); if (ko > lim) S0[r] = -__builtin_inff(); if (ko + 32 > lim) S1[r] = -__builtin_inff(); }
            }
            float pm = S0[0];
#pragma unroll
            for (int r = 1; r < 16; ++r) pm = fmaxf(pm, S0[r]);
#pragma unroll
            for (int r = 0; r < 16; ++r) pm = fmaxf(pm, S1[r]);
            pm = xmax32(pm);
#ifdef MLA_NODEFER
            {
#else
            if (!__all(pm <= m + 8.0f)) {
#endif
                const float mn = fmaxf(m, pm), alpha = __builtin_amdgcn_exp2f(m - mn); m = mn; l *= alpha;
#pragma unroll
                for (int d = 0; d < 4; ++d)
#pragma unroll
                    for (int r = 0; r < 16; ++r) O[d][r] *= alpha;
            }
            float ps = 0.f;
#pragma unroll
            for (int r = 0; r < 16; ++r) { S0[r] = __builtin_amdgcn_exp2f(S0[r] - m); S1[r] = __builtin_amdgcn_exp2f(S1[r] - m); ps += S0[r] + S1[r]; }
            l += ps;
            bf16x8 pf[4];
#pragma unroll
            for (int s = 0; s < 2; ++s) {
                u32x4 w0 = {cvtpk(S0[8 * s + 0], S0[8 * s + 1]), cvtpk(S0[8 * s + 2], S0[8 * s + 3]), cvtpk(S0[8 * s + 4], S0[8 * s + 5]), cvtpk(S0[8 * s + 6], S0[8 * s + 7])};
                u32x4 w1 = {cvtpk(S1[8 * s + 0], S1[8 * s + 1]), cvtpk(S1[8 * s + 2], S1[8 * s + 3]), cvtpk(S1[8 * s + 4], S1[8 * s + 5]), cvtpk(S1[8 * s + 6], S1[8 * s + 7])};
                pf[s] = __builtin_bit_cast(bf16x8, w0); pf[2 + s] = __builtin_bit_cast(bf16x8, w1); }
#pragma unroll
            for (int kc = 0; kc < 4; ++kc)
#pragma unroll
                for (int d = 0; d < 4; ++d) { const bf16x8 a = *(const LAS bf16x8*)(kb + VT_OFF + d * 32 * VT_ROW + vt_l + kc * 32);
                    O[d] = __builtin_amdgcn_mfma_f32_32x32x16_bf16(a, pf[kc], O[d], 0, 0, 0); }
        }
#ifdef MLA_SERIAL
        __syncthreads(); if (j + 1 < ntile) MLA_ISSUE(j + 1, BUF_BYTES - bufb);
#endif
        if (bg.nfly) asm volatile("s_waitcnt vmcnt(4)" ::: "memory"); else asm volatile("s_waitcnt vmcnt(0)" ::: "memory");
        asm volatile("" ::: "memory"); asm volatile("s_waitcnt lgkmcnt(0)" ::: "memory"); __builtin_amdgcn_s_barrier(); asm volatile("" ::: "memory");
    }
    const float il = 1.0f / xsum32(l);
    bf16* orow = MIX + (size_t)(q0 + c) * DM + 3072 + h * 128 + 4 * hi;
#pragma unroll
    for (int d = 0; d < 4; ++d)
#pragma unroll
        for (int g = 0; g < 4; ++g) { u32x2 w = {cvtpk(O[d][4 * g + 0] * il, O[d][4 * g + 1] * il), cvtpk(O[d][4 * g + 2] * il, O[d][4 * g + 3] * il)};
            *(u32x2*)(orow + 32 * d + 8 * g) = w; }
#undef MLA_ISSUE
}
__device__ __forceinline__ void qk_pipe(f32x16& S0, f32x16& S1, unsigned aN, unsigned aR, const bf16x8 (&qf)[12]) {
    bf16x8 f0, f1, f2, f3, f4, f5;
    asm volatile(
        "ds_read_b128 %2, %8 offset:0\n\t"
        "ds_read_b128 %3, %8 offset:8704\n\t"
        "ds_read_b128 %4, %8 offset:32\n\t"
        "ds_read_b128 %5, %8 offset:8736\n\t"
        "ds_read_b128 %6, %8 offset:64\n\t"
        "ds_read_b128 %7, %8 offset:8768\n\t"
        "s_waitcnt lgkmcnt(5)\n\t"
        "v_mfma_f32_32x32x16_bf16 %0, %2, %10, 0\n\t"
        "ds_read_b128 %2, %8 offset:96\n\t"
        "s_waitcnt lgkmcnt(5)\n\t"
        "v_mfma_f32_32x32x16_bf16 %1, %3, %10, 0\n\t"
        "ds_read_b128 %3, %8 offset:8800\n\t"
        "s_waitcnt lgkmcnt(5)\n\t"
        "v_mfma_f32_32x32x16_bf16 %0, %4, %11, %0\n\t"
        "ds_read_b128 %4, %8 offset:128\n\t"
        "s_waitcnt lgkmcnt(5)\n\t"
        "v_mfma_f32_32x32x16_bf16 %1, %5, %11, %1\n\t"
        "ds_read_b128 %5, %8 offset:8832\n\t"
        "s_waitcnt lgkmcnt(5)\n\t"
        "v_mfma_f32_32x32x16_bf16 %0, %6, %12, %0\n\t"
        "ds_read_b128 %6, %8 offset:160\n\t"
        "s_waitcnt lgkmcnt(5)\n\t"
        "v_mfma_f32_32x32x16_bf16 %1, %7, %12, %1\n\t"
        "ds_read_b128 %7, %8 offset:8864\n\t"
        "s_waitcnt lgkmcnt(5)\n\t"
        "v_mfma_f32_32x32x16_bf16 %0, %2, %13, %0\n\t"
        "ds_read_b128 %2, %8 offset:192\n\t"
        "s_waitcnt lgkmcnt(5)\n\t"
        "v_mfma_f32_32x32x16_bf16 %1, %3, %13, %1\n\t"
        "ds_read_b128 %3, %8 offset:8896\n\t"
        "s_waitcnt lgkmcnt(5)\n\t"
        "v_mfma_f32_32x32x16_bf16 %0, %4, %14, %0\n\t"
        "ds_read_b128 %4, %8 offset:224\n\t"
        "s_waitcnt lgkmcnt(5)\n\t"
        "v_mfma_f32_32x32x16_bf16 %1, %5, %14, %1\n\t"
        "ds_read_b128 %5, %8 offset:8928\n\t"
        "s_waitcnt lgkmcnt(5)\n\t"
        "v_mfma_f32_32x32x16_bf16 %0, %6, %15, %0\n\t"
        "ds_read_b128 %6, %9 offset:0\n\t"
        "s_waitcnt lgkmcnt(5)\n\t"
        "v_mfma_f32_32x32x16_bf16 %1, %7, %15, %1\n\t"
        "ds_read_b128 %7, %9 offset:4608\n\t"
        "s_waitcnt lgkmcnt(5)\n\t"
        "v_mfma_f32_32x32x16_bf16 %0, %2, %16, %0\n\t"
        "ds_read_b128 %2, %9 offset:32\n\t"
        "s_waitcnt lgkmcnt(5)\n\t"
        "v_mfma_f32_32x32x16_bf16 %1, %3, %16, %1\n\t"
        "ds_read_b128 %3, %9 offset:4640\n\t"
        "s_waitcnt lgkmcnt(5)\n\t"
        "v_mfma_f32_32x32x16_bf16 %0, %4, %17, %0\n\t"
        "ds_read_b128 %4, %9 offset:64\n\t"
        "s_waitcnt lgkmcnt(5)\n\t"
        "v_mfma_f32_32x32x16_bf16 %1, %5, %17, %1\n\t"
        "ds_read_b128 %5, %9 offset:4672\n\t"
        "s_waitcnt lgkmcnt(5)\n\t"
        "v_mfma_f32_32x32x16_bf16 %0, %6, %18, %0\n\t"
        "ds_read_b128 %6, %9 offset:96\n\t"
        "s_waitcnt lgkmcnt(5)\n\t"
        "v_mfma_f32_32x32x16_bf16 %1, %7, %18, %1\n\t"
        "ds_read_b128 %7, %9 offset:4704\n\t"
        "s_waitcnt lgkmcnt(5)\n\t"
        "v_mfma_f32_32x32x16_bf16 %0, %2, %19, %0\n\t"
        "s_waitcnt lgkmcnt(4)\n\t"
        "v_mfma_f32_32x32x16_bf16 %1, %3, %19, %1\n\t"
        "s_waitcnt lgkmcnt(3)\n\t"
        "v_mfma_f32_32x32x16_bf16 %0, %4, %20, %0\n\t"
        "s_waitcnt lgkmcnt(2)\n\t"
        "v_mfma_f32_32x32x16_bf16 %1, %5, %20, %1\n\t"
        "s_waitcnt lgkmcnt(1)\n\t"
        "v_mfma_f32_32x32x16_bf16 %0, %6, %21, %0\n\t"
        "s_waitcnt lgkmcnt(0)\n\t"
        "v_mfma_f32_32x32x16_bf16 %1, %7, %21, %1\n\t"
        "s_nop 15\n\t"
        "s_nop 3\n\t"
        : "=&v"(S0), "=&v"(S1), "=&v"(f0), "=&v"(f1), "=&v"(f2), "=&v"(f3), "=&v"(f4), "=&v"(f5)
        : "v"(aN), "v"(aR), "v"(qf[0]), "v"(qf[1]), "v"(qf[2]), "v"(qf[3]), "v"(qf[4]), "v"(qf[5]), "v"(qf[6]), "v"(qf[7]), "v"(qf[8]), "v"(qf[9]), "v"(qf[10]), "v"(qf[11])
        : "memory");
}
struct PvFrag { bf16x8 f0, f1, f2, f3, f4, f5; };
__device__ __forceinline__ void pv_head(PvFrag& t, unsigned aV) {
    asm volatile(
        "ds_read_b128 %0, %6 offset:0\n\t"
        "ds_read_b128 %1, %6 offset:4608\n\t"
        "ds_read_b128 %2, %6 offset:9216\n\t"
        "ds_read_b128 %3, %6 offset:13824\n\t"
        "ds_read_b128 %4, %6 offset:32\n\t"
        "ds_read_b128 %5, %6 offset:4640\n\t"
        : "=&v"(t.f0), "=&v"(t.f1), "=&v"(t.f2), "=&v"(t.f3), "=&v"(t.f4), "=&v"(t.f5)
        : "v"(aV)
        : "memory");
}
__device__ __forceinline__ void pv_tail(f32x16 (&O)[4], PvFrag& t, unsigned aV, const bf16x8 (&pf)[4]) {
    asm volatile(
        "s_waitcnt lgkmcnt(5)\n\t"
        "v_mfma_f32_32x32x16_bf16 %0, %4, %11, %0\n\t"
        "ds_read_b128 %4, %10 offset:9248\n\t"
        "s_waitcnt lgkmcnt(5)\n\t"
        "v_mfma_f32_32x32x16_bf16 %1, %5, %11, %1\n\t"
        "ds_read_b128 %5, %10 offset:13856\n\t"
        "s_waitcnt lgkmcnt(5)\n\t"
        "v_mfma_f32_32x32x16_bf16 %2, %6, %11, %2\n\t"
        "ds_read_b128 %6, %10 offset:64\n\t"
        "s_waitcnt lgkmcnt(5)\n\t"
        "v_mfma_f32_32x32x16_bf16 %3, %7, %11, %3\n\t"
        "ds_read_b128 %7, %10 offset:4672\n\t"
        "s_waitcnt lgkmcnt(5)\n\t"
        "v_mfma_f32_32x32x16_bf16 %0, %8, %12, %0\n\t"
        "ds_read_b128 %8, %10 offset:9280\n\t"
        "s_waitcnt lgkmcnt(5)\n\t"
        "v_mfma_f32_32x32x16_bf16 %1, %9, %12, %1\n\t"
        "ds_read_b128 %9, %10 offset:13888\n\t"
        "s_waitcnt lgkmcnt(5)\n\t"
        "v_mfma_f32_32x32x16_bf16 %2, %4, %12, %2\n\t"
        "ds_read_b128 %4, %10 offset:96\n\t"
        "s_waitcnt lgkmcnt(5)\n\t"
        "v_mfma_f32_32x32x16_bf16 %3, %5, %12, %3\n\t"
        "ds_read_b128 %5, %10 offset:4704\n\t"
        "s_waitcnt lgkmcnt(5)\n\t"
        "v_mfma_f32_32x32x16_bf16 %0, %6, %13, %0\n\t"
        "ds_read_b128 %6, %10 offset:9312\n\t"
        "s_waitcnt lgkmcnt(5)\n\t"
        "v_mfma_f32_32x32x16_bf16 %1, %7, %13, %1\n\t"
        "ds_read_b128 %7, %10 offset:13920\n\t"
        "s_waitcnt lgkmcnt(5)\n\t"
        "v_mfma_f32_32x32x16_bf16 %2, %8, %13, %2\n\t"
        "s_waitcnt lgkmcnt(4)\n\t"
        "v_mfma_f32_32x32x16_bf16 %3, %9, %13, %3\n\t"
        "s_waitcnt lgkmcnt(3)\n\t"
        "v_mfma_f32_32x32x16_bf16 %0, %4, %14, %0\n\t"
        "s_waitcnt lgkmcnt(2)\n\t"
        "v_mfma_f32_32x32x16_bf16 %1, %5, %14, %1\n\t"
        "s_waitcnt lgkmcnt(1)\n\t"
        "v_mfma_f32_32x32x16_bf16 %2, %6, %14, %2\n\t"
        "s_waitcnt lgkmcnt(0)\n\t"
        "v_mfma_f32_32x32x16_bf16 %3, %7, %14, %3\n\t"
        "s_nop 15\n\t"
        "s_nop 3\n\t"
        : "+v"(O[0]), "+v"(O[1]), "+v"(O[2]), "+v"(O[3]), "+v"(t.f0), "+v"(t.f1), "+v"(t.f2), "+v"(t.f3), "+v"(t.f4), "+v"(t.f5)
        : "v"(aV), "v"(pf[0]), "v"(pf[1]), "v"(pf[2]), "v"(pf[3])
        : "memory");
}
constexpr int KB_BYTES = KN_BYTES + KR_BYTES, AB_V_OFF = 3 * KB_BYTES, AB_LDS_BYTES = AB_V_OFF + 2 * VT_BYTES, NP_K2 = NP_KN + NP_KR;
template <class BG>
__device__ __forceinline__ void unit_ab(LAS unsigned char* lds, const bf16* Q, const bf16* KN, const bf16* KR, const bf16* VT, bf16* MIX, int h, int qb, BG& bg) {
    int tid_ = threadIdx.x; asm volatile("" : "+v"(tid_));
    const int lane = tid_ & 63, wave = __builtin_amdgcn_readfirstlane(tid_ >> 6), c = lane & 31, hi = lane >> 5;
    const bool grpB = wave >= 4;
    const int q0 = qb * 256 + wave * 32, ntile = 4 * (qb + 1);
    const int xP = (wave == 0) ? 16 : (wave == 1) ? NP_KN + 8 : NP_K2 + 14 + wave;
    unsigned vK0 = piece_voff(2 * wave, lane), vK1 = piece_voff(2 * wave + 1, lane), vR = piece_voff(NP_KN + wave, lane), vV0 = piece_voff(NP_K2 + 2 * wave, lane), vV1 = piece_voff(NP_K2 + 2 * wave + 1, lane), vX = piece_voff(wave < 4 ? xP : 0, lane);
    const char* knb = (const char*)KN + (size_t)h * 256; const char* krb = (const char*)KR; const char* vtb = (const char*)VT + (size_t)h * 128 * (M * 2);
#define AB_DMA(gb, vo, loff) do { asm volatile("" : "+v"(vo));     \
        __builtin_amdgcn_global_load_lds((const unsigned*)((gb) + (vo)), (LAS unsigned*)(lds + (loff)), 16, 0, 0); } while (0)
#define AB_ISSUE_K(t, kofs) do { const size_t key0_ = (size_t)(t) * 64; const char* bn_ = knb + key0_ * 2048; const char* br_ = krb + key0_ * 128; const int lo_ = (kofs) + wave * 2048; \
        AB_DMA(bn_, vK0, lo_); AB_DMA(bn_, vK1, lo_ + 1024); AB_DMA(br_, vR, (kofs) + (NP_KN + wave) * 1024); \
        if (wave == 0) AB_DMA(bn_, vX, (kofs) + 16 * 1024); else if (wave == 1) AB_DMA(br_, vX, (kofs) + (NP_KN + 8) * 1024); } while (0)
#define AB_ISSUE_V(t, vofs) do { const char* bv_ = vtb + (size_t)(t) * 128; const int lo_ = AB_V_OFF + (vofs) + wave * 2048; \
        AB_DMA(bv_, vV0, lo_); AB_DMA(bv_, vV1, lo_ + 1024); \
        if (wave == 2 || wave == 3) AB_DMA(bv_, vX, AB_V_OFF + (vofs) + (14 + wave) * 1024); } while (0)
    bf16x8 qf[12];
    { const bf16* qrow = Q + (size_t)(q0 + c) * 1536 + h * 192 + 8 * hi;
#pragma unroll
      for (int ch = 0; ch < 12; ++ch) qf[ch] = *(const bf16x8*)(qrow + 16 * ch); }
    AB_ISSUE_K(0, 0); AB_ISSUE_V(0, 0); AB_ISSUE_K(1, KB_BYTES);
    f32x16 O[4];
#pragma unroll
    for (int d = 0; d < 4; ++d)
#pragma unroll
        for (int r = 0; r < 16; ++r) O[d][r] = 0.f;
    float m = -1e30f, l = 0.f;
    const int kn_l = c * KN_ROW + hi * 16, kr_l = c * KR_ROW + hi * 16, vt_l = c * VT_ROW + hi * 16;
    const unsigned ldsbase = (unsigned)(size_t)lds;
#define AB_QK(kofs_) qk_pipe(S0, S1, ldsbase + (unsigned)(kofs_) + (unsigned)kn_l, ldsbase + (unsigned)(kofs_) + (unsigned)(KN_BYTES + kr_l), qf)
#define AB_SMPV(key0_, vofs_) do { PvFrag vf_; const unsigned av_ = ldsbase + (unsigned)(AB_V_OFF + (vofs_)) + (unsigned)vt_l; pv_head(vf_, av_); \
        if ((key0_) + 63 > q0) { const int lim = q0 + c - (key0_) - 8 * hi; \
            _Pragma("unroll") for (int r = 0; r < 16; ++r) { const int ko = 16 * (r >> 3) + (r & 7); if (ko > lim) S0[r] = -__builtin_inff(); if (ko + 32 > lim) S1[r] = -__builtin_inff(); } } \
        float pm = S0[0]; \
        _Pragma("unroll") for (int r = 1; r < 16; ++r) pm = fmaxf(pm, S0[r]); \
        _Pragma("unroll") for (int r = 0; r < 16; ++r) pm = fmaxf(pm, S1[r]); \
        pm = xmax32(pm); \
        if (!__all(pm <= m + 8.0f)) { const float mn = fmaxf(m, pm), alpha = __builtin_amdgcn_exp2f(m - mn); m = mn; l *= alpha; \
            _Pragma("unroll") for (int d = 0; d < 4; ++d) _Pragma("unroll") for (int r = 0; r < 16; ++r) O[d][r] *= alpha; } \
        float ps = 0.f; \
        _Pragma("unroll") for (int r = 0; r < 16; ++r) { S0[r] = __builtin_amdgcn_exp2f(S0[r] - m); S1[r] = __builtin_amdgcn_exp2f(S1[r] - m); ps += S0[r] + S1[r]; } \
        l += ps; \
        bf16x8 pf[4]; \
        _Pragma("unroll") for (int s = 0; s < 2; ++s) { \
            u32x4 w0 = {cvtpk(S0[8 * s + 0], S0[8 * s + 1]), cvtpk(S0[8 * s + 2], S0[8 * s + 3]), cvtpk(S0[8 * s + 4], S0[8 * s + 5]), cvtpk(S0[8 * s + 6], S0[8 * s + 7])}; \
            u32x4 w1 = {cvtpk(S1[8 * s + 0], S1[8 * s + 1]), cvtpk(S1[8 * s + 2], S1[8 * s + 3]), cvtpk(S1[8 * s + 4], S1[8 * s + 5]), cvtpk(S1[8 * s + 6], S1[8 * s + 7])}; \
            pf[s] = __builtin_bit_cast(bf16x8, w0); pf[2 + s] = __builtin_bit_cast(bf16x8, w1); } \
        pv_tail(O, vf_, av_, pf); } while (0)
    asm volatile("s_waitcnt vmcnt(0)" ::: "memory"); __syncthreads();
    f32x16 S0, S1;
    int kc0 = 0, kc2 = 2 * KB_BYTES, kc1 = KB_BYTES;
#define AB_SYNC(i) do { \
        if (bg.nfly) asm volatile("s_waitcnt vmcnt(4)" ::: "memory"); else asm volatile("s_waitcnt vmcnt(0)" ::: "memory"); \
        asm volatile("" ::: "memory"); asm volatile("s_waitcnt lgkmcnt(0)" ::: "memory"); __builtin_amdgcn_s_barrier(); asm volatile("" ::: "memory"); } while (0)
#define AB_FEED(i) do { \
        if ((i) + 2 < ntile) AB_ISSUE_K((i) + 2, kc2); \
        if ((i) + 1 < ntile) AB_ISSUE_V((i) + 1, (((i) + 1) & 1) * VT_BYTES); } while (0)
#define AB_BG(i) do { bg.pre(i); bg.post(i); } while (0)
    for (int j = 0; j < ntile; ++j) {
        const int key0 = j * 64; const bool act = key0 <= q0 + 31;
        if (!grpB) AB_SYNC(j);
        if (act) AB_QK(kc0);
        if (grpB) AB_SYNC(j);
        AB_FEED(j);
        if (!grpB) AB_BG(j);
        if (act) AB_SMPV(key0, (j & 1) * VT_BYTES);
        if (grpB) AB_BG(j);
        { const int t = kc0; kc0 = kc1; kc1 = kc2; kc2 = t; }
    }
    if (bg.nfly) asm volatile("s_waitcnt vmcnt(4)" ::: "memory"); else asm volatile("s_waitcnt vmcnt(0)" ::: "memory");
    asm volatile("" ::: "memory"); asm volatile("s_waitcnt lgkmcnt(0)" ::: "memory"); __builtin_amdgcn_s_barrier(); asm volatile("" ::: "memory");
#undef AB_SYNC
#undef AB_FEED
#undef AB_BG
    const float il = 1.0f / xsum32(l);
    bf16* orow = MIX + (size_t)(q0 + c) * DM + 3072 + h * 128 + 4 * hi;
#pragma unroll
    for (int d = 0; d < 4; ++d)
#pragma unroll
        for (int g = 0; g < 4; ++g) { u32x2 w = {cvtpk(O[d][4 * g + 0] * il, O[d][4 * g + 1] * il), cvtpk(O[d][4 * g + 2] * il, O[d][4 * g + 3] * il)};
            *(u32x2*)(orow + 32 * d + 8 * g) = w; }
#undef AB_ISSUE_K
#undef AB_DMA
#undef AB_ISSUE_V
#undef AB_QK
#undef AB_SMPV
}
static_assert(AB_LDS_BYTES + 3 * 4224 <= 131072, "mla two-group LDS map");
}
namespace dil {
typedef float f32x16 __attribute__((ext_vector_type(16)));
typedef short bf16x8 __attribute__((ext_vector_type(8)));
typedef short s16x4 __attribute__((ext_vector_type(4)));
typedef unsigned u32x4 __attribute__((ext_vector_type(4)));
typedef unsigned u32x2 __attribute__((ext_vector_type(2)));
constexpr int K_ROW = 272, K_BYTES = 64 * K_ROW, V_BYTES = 64 * 256, BUF_BYTES = K_BYTES + V_BYTES, NP_K = K_BYTES / 1024, NP_V = V_BYTES / 1024, NPIECE = NP_K + NP_V;
constexpr int TAB_OFF = 3 * BUF_BYTES;
static_assert(NP_K * 1024 == K_BYTES && TAB_OFF + 1024 <= 131072, "dil LDS map");
constexpr float LOG2E = 1.4426950408889634f;

__device__ __forceinline__ unsigned piece_voff(int P, int lane, unsigned dstride) {
    if (P < NP_K) { const int s = 64 * P + lane, rho = s / 17; int ch = s - rho * 17; if (ch == 16) ch = 0; const int keyl = (rho & 32) | mla::swap23(rho & 31); return (unsigned)keyl * dstride + (unsigned)(ch * 16); }
    { const int row = 4 * (P - NP_K) + (lane >> 4), chp = lane & 15, ch = chp ^ (((row & 3) << 2) | ((row >> 2) & 3)); return (unsigned)row * dstride + (unsigned)(ch * 16); }
}

__device__ __forceinline__ void qk_pipe(f32x16& S0, f32x16& S1, unsigned a, const bf16x8 (&qf)[8]) {
    bf16x8 f0, f1, f2, f3, f4, f5;
    asm volatile(
        "ds_read_b128 %2, %8 offset:0\n\t"
        "ds_read_b128 %3, %8 offset:8704\n\t"
        "ds_read_b128 %4, %8 offset:32\n\t"
        "ds_read_b128 %5, %8 offset:8736\n\t"
        "ds_read_b128 %6, %8 offset:64\n\t"
        "ds_read_b128 %7, %8 offset:8768\n\t"
        "s_waitcnt lgkmcnt(5)\n\t"
        "v_mfma_f32_32x32x16_bf16 %0, %2, %9, 0\n\t"
        "ds_read_b128 %2, %8 offset:96\n\t"
        "s_waitcnt lgkmcnt(5)\n\t"
        "v_mfma_f32_32x32x16_bf16 %1, %3, %9, 0\n\t"
        "ds_read_b128 %3, %8 offset:8800\n\t"
        "s_waitcnt lgkmcnt(5)\n\t"
        "v_mfma_f32_32x32x16_bf16 %0, %4, %10, %0\n\t"
        "ds_read_b128 %4, %8 offset:128\n\t"
        "s_waitcnt lgkmcnt(5)\n\t"
        "v_mfma_f32_32x32x16_bf16 %1, %5, %10, %1\n\t"
        "ds_read_b128 %5, %8 offset:8832\n\t"
        "s_waitcnt lgkmcnt(5)\n\t"
        "v_mfma_f32_32x32x16_bf16 %0, %6, %11, %0\n\t"
        "ds_read_b128 %6, %8 offset:160\n\t"
        "s_waitcnt lgkmcnt(5)\n\t"
        "v_mfma_f32_32x32x16_bf16 %1, %7, %11, %1\n\t"
        "ds_read_b128 %7, %8 offset:8864\n\t"
        "s_waitcnt lgkmcnt(5)\n\t"
        "v_mfma_f32_32x32x16_bf16 %0, %2, %12, %0\n\t"
        "ds_read_b128 %2, %8 offset:192\n\t"
        "s_waitcnt lgkmcnt(5)\n\t"
        "v_mfma_f32_32x32x16_bf16 %1, %3, %12, %1\n\t"
        "ds_read_b128 %3, %8 offset:8896\n\t"
        "s_waitcnt lgkmcnt(5)\n\t"
        "v_mfma_f32_32x32x16_bf16 %0, %4, %13, %0\n\t"
        "ds_read_b128 %4, %8 offset:224\n\t"
        "s_waitcnt lgkmcnt(5)\n\t"
        "v_mfma_f32_32x32x16_bf16 %1, %5, %13, %1\n\t"
        "ds_read_b128 %5, %8 offset:8928\n\t"
        "s_waitcnt lgkmcnt(5)\n\t"
        "v_mfma_f32_32x32x16_bf16 %0, %6, %14, %0\n\t"
        "s_waitcnt lgkmcnt(4)\n\t"
        "v_mfma_f32_32x32x16_bf16 %1, %7, %14, %1\n\t"
        "s_waitcnt lgkmcnt(3)\n\t"
        "v_mfma_f32_32x32x16_bf16 %0, %2, %15, %0\n\t"
        "s_waitcnt lgkmcnt(2)\n\t"
        "v_mfma_f32_32x32x16_bf16 %1, %3, %15, %1\n\t"
        "s_waitcnt lgkmcnt(1)\n\t"
        "v_mfma_f32_32x32x16_bf16 %0, %4, %16, %0\n\t"
        "s_waitcnt lgkmcnt(0)\n\t"
        "v_mfma_f32_32x32x16_bf16 %1, %5, %16, %1\n\t"
        "s_nop 15\n\t"
        "s_nop 3\n\t"
        : "=&v"(S0), "=&v"(S1), "=&v"(f0), "=&v"(f1), "=&v"(f2), "=&v"(f3), "=&v"(f4), "=&v"(f5)
        : "v"(a), "v"(qf[0]), "v"(qf[1]), "v"(qf[2]), "v"(qf[3]), "v"(qf[4]), "v"(qf[5]), "v"(qf[6]), "v"(qf[7])
        : "memory");
}
__device__ __forceinline__ void unit(LAS unsigned char* lds, const bf16* PROJ, const float* BIAS, float* DSO, float* DSML, bf16* MIX, int b, int r, int h, int nb) {
    int tid_ = threadIdx.x; asm volatile("" : "+v"(tid_));
    const int lane = tid_ & 63, wave = __builtin_amdgcn_readfirstlane(tid_ >> 6), c = lane & 31, hi = lane >> 5;
    const int d = 1 << (2 * b); const unsigned dstride = (unsigned)d * (INWP * 2);
    if (tid_ < 256) { const int dist = tid_ - 64; ((LAS float*)(lds + TAB_OFF))[tid_] = (dist >= 0 && dist <= 128) ? BIAS[(b * 129 + dist) * 8 + h] * LOG2E : -__builtin_inff(); }
    unsigned voff[5];
#pragma unroll
    for (int k = 0; k < 5; ++k) voff[k] = piece_voff((wave + 8 * k) < NPIECE ? (wave + 8 * k) : 0, lane, dstride);
    const char* kg = (const char*)PROJ + ((size_t)r * INWP + C_K + h * 128) * 2; const char* vg = (const char*)PROJ + ((size_t)r * INWP + C_V + h * 128) * 2;
#define DIL_ISSUE(kt, bufb) do { const size_t tb_ = (size_t)(kt) * 64 * dstride; \
        _Pragma("unroll") for (int k = 0; k < 5; ++k) { const int P = wave + 8 * k; if (P < NPIECE) { \
            const char* gb = ((P < NP_K) ? kg : vg) + tb_; asm volatile("" : "+v"(voff[k])); \
            __builtin_amdgcn_global_load_lds((const unsigned*)(gb + voff[k]), (LAS unsigned*)(lds + (bufb) + P * 1024), 16, 0, 0); } } } while (0)
    const int nq = 256 * nb + 32 * wave + c;
    const size_t tokq = (size_t)nq * d + r;
    bf16x8 qf[8];
    { const bf16* qrow = PROJ + tokq * INWP + C_Q + h * 128 + 8 * hi;
#pragma unroll
      for (int ch = 0; ch < 8; ++ch) qf[ch] = *(const bf16x8*)(qrow + 16 * ch); }
    const int kt0 = (4 * nb - 2) > 0 ? (4 * nb - 2) : 0, kt1 = 4 * nb + 3;
    DIL_ISSUE(kt0, 0);
    f32x16 O[4]; float m, l;
    bf16* so = (bf16*)DSO + (tokq * 8 + h) * 128 + 4 * hi; float* sml = DSML + (tokq * 8 + h) * 2;
    if (b == 0) {
#pragma unroll
        for (int q4 = 0; q4 < 4; ++q4)
#pragma unroll
            for (int i = 0; i < 16; ++i) O[q4][i] = 0.f;
        m = -1e30f; l = 0.f;
    } else {
#pragma unroll
        for (int q4 = 0; q4 < 4; ++q4)
#pragma unroll
            for (int g = 0; g < 4; ++g) { const u32x2 v = *(const u32x2*)(so + 32 * q4 + 8 * g); O[q4][4 * g + 0] = bflo(v.x); O[q4][4 * g + 1] = bfhi(v.x); O[q4][4 * g + 2] = bflo(v.y); O[q4][4 * g + 3] = bfhi(v.y); }
        m = sml[0]; l = hi ? 0.f : sml[1];
    }
    const int k_l = c * K_ROW + hi * 16;
    unsigned vt[2];
    { const int blk = (lane >> 4) & 1, q = (lane & 15) >> 2, p = lane & 3;
#pragma unroll
      for (int t = 0; t < 2; ++t) vt[t] = (unsigned)(256 * (8 * hi + 4 * t + q) + 16 * ((q << 2) | ((2 * blk + (p >> 1)) ^ (2 * hi + t))) + 8 * (p & 1)); }
    const unsigned ldsbase = (unsigned)(size_t)lds;
    DIL_ISSUE(kt0 + 1, BUF_BYTES);
    asm volatile("s_waitcnt vmcnt(4)" ::: "memory"); asm volatile("s_waitcnt lgkmcnt(0)" ::: "memory"); __builtin_amdgcn_s_barrier(); asm volatile("" ::: "memory");
    const float SC = DIL_SCALE * LOG2E;
    int bufb = 0, bufn = 2 * BUF_BYTES;
    for (int kt = kt0; kt <= kt1; ++kt) {
        if (kt + 2 <= kt1) DIL_ISSUE(kt + 2, bufn);
        const int klo = 4 * nb + (wave >> 1) - 2;
        if (kt >= klo && kt <= klo + 2) {
            f32x16 S0, S1;
            qk_pipe(S0, S1, ldsbase + (unsigned)bufb + (unsigned)k_l, qf);
            { const int dbase = nq - 64 * kt - 8 * hi + 64;
              const LAS float* tp = (const LAS float*)(lds + TAB_OFF) + (dbase - 63);
#pragma unroll
              for (int i = 0; i < 16; ++i) { const int cr = 16 * (i >> 3) + (i & 7); S0[i] = S0[i] * SC + tp[63 - cr]; S1[i] = S1[i] * SC + tp[63 - cr - 32]; } }
            float pm = S0[0];
#pragma unroll
            for (int i = 1; i < 16; ++i) pm = fmaxf(pm, S0[i]);
#pragma unroll
            for (int i = 0; i < 16; ++i) pm = fmaxf(pm, S1[i]);
            pm = mla::xmax32(pm);
            if (!__all(pm <= m + 8.0f)) {
                const float mn = fmaxf(m, pm), alpha = __builtin_amdgcn_exp2f(m - mn); m = mn; l *= alpha;
#pragma unroll
                for (int q4 = 0; q4 < 4; ++q4)
#pragma unroll
                    for (int i = 0; i < 16; ++i) O[q4][i] *= alpha;
            }
            float ps = 0.f;
#pragma unroll
            for (int i = 0; i < 16; ++i) { S0[i] = __builtin_amdgcn_exp2f(S0[i] - m); S1[i] = __builtin_amdgcn_exp2f(S1[i] - m); ps += S0[i] + S1[i]; }
            l += ps;
            bf16x8 pf[4];
#pragma unroll
            for (int s = 0; s < 2; ++s) {
                u32x4 w0 = {mla::cvtpk(S0[8 * s + 0], S0[8 * s + 1]), mla::cvtpk(S0[8 * s + 2], S0[8 * s + 3]), mla::cvtpk(S0[8 * s + 4], S0[8 * s + 5]), mla::cvtpk(S0[8 * s + 6], S0[8 * s + 7])};
                u32x4 w1 = {mla::cvtpk(S1[8 * s + 0], S1[8 * s + 1]), mla::cvtpk(S1[8 * s + 2], S1[8 * s + 3]), mla::cvtpk(S1[8 * s + 4], S1[8 * s + 5]), mla::cvtpk(S1[8 * s + 6], S1[8 * s + 7])};
                pf[s] = __builtin_bit_cast(bf16x8, w0); pf[2 + s] = __builtin_bit_cast(bf16x8, w1); }
            const unsigned vb = ldsbase + (unsigned)bufb + K_BYTES;
            const unsigned a00 = vb + vt[0], a01 = vb + vt[1], a10 = vb + (vt[0] ^ 64u), a11 = vb + (vt[1] ^ 64u), a20 = vb + (vt[0] ^ 128u), a21 = vb + (vt[1] ^ 128u), a30 = vb + (vt[0] ^ 192u), a31 = vb + (vt[1] ^ 192u);
#define DIL_PV(kc) do { s16x4 r00, r01, r10, r11, r20, r21, r30, r31; \
            asm volatile("ds_read_b64_tr_b16 %0, %8 offset:%16\n\tds_read_b64_tr_b16 %1, %9 offset:%16\n\tds_read_b64_tr_b16 %2, %10 offset:%16\n\tds_read_b64_tr_b16 %3, %11 offset:%16\n\t" \
                         "ds_read_b64_tr_b16 %4, %12 offset:%16\n\tds_read_b64_tr_b16 %5, %13 offset:%16\n\tds_read_b64_tr_b16 %6, %14 offset:%16\n\tds_read_b64_tr_b16 %7, %15 offset:%16\n\ts_waitcnt lgkmcnt(0)" \
                         : "=&v"(r00), "=&v"(r01), "=&v"(r10), "=&v"(r11), "=&v"(r20), "=&v"(r21), "=&v"(r30), "=&v"(r31) \
                         : "v"(a00), "v"(a01), "v"(a10), "v"(a11), "v"(a20), "v"(a21), "v"(a30), "v"(a31), "n"(4096 * (kc)) : "memory"); \
            O[0] = __builtin_amdgcn_mfma_f32_32x32x16_bf16(__builtin_shufflevector(r00, r01, 0, 1, 2, 3, 4, 5, 6, 7), pf[kc], O[0], 0, 0, 0); \
            O[1] = __builtin_amdgcn_mfma_f32_32x32x16_bf16(__builtin_shufflevector(r10, r11, 0, 1, 2, 3, 4, 5, 6, 7), pf[kc], O[1], 0, 0, 0); \
            O[2] = __builtin_amdgcn_mfma_f32_32x32x16_bf16(__builtin_shufflevector(r20, r21, 0, 1, 2, 3, 4, 5, 6, 7), pf[kc], O[2], 0, 0, 0); \
            O[3] = __builtin_amdgcn_mfma_f32_32x32x16_bf16(__builtin_shufflevector(r30, r31, 0, 1, 2, 3, 4, 5, 6, 7), pf[kc], O[3], 0, 0, 0); } while (0)
            DIL_PV(0); DIL_PV(1); DIL_PV(2); DIL_PV(3);
#undef DIL_PV
        }
        if (kt + 2 <= kt1) asm volatile("s_waitcnt vmcnt(4)" ::: "memory"); else asm volatile("s_waitcnt vmcnt(0)" ::: "memory");
        asm volatile("s_waitcnt lgkmcnt(0)" ::: "memory"); __builtin_amdgcn_s_barrier(); asm volatile("" ::: "memory");
        { const int t = bufb + BUF_BYTES; bufn = bufb; bufb = (t == 3 * BUF_BYTES) ? 0 : t; }
    }
    const float lt = mla::xsum32(l);
    if (b == 2) {
        const float il = 1.0f / lt;
        bf16* orow = MIX + tokq * DM + 1024 + h * 128 + 4 * hi;
#pragma unroll
        for (int q4 = 0; q4 < 4; ++q4)
#pragma unroll
            for (int g = 0; g < 4; ++g) { u32x2 w = {mla::cvtpk(O[q4][4 * g + 0] * il, O[q4][4 * g + 1] * il), mla::cvtpk(O[q4][4 * g + 2] * il, O[q4][4 * g + 3] * il)};
                *(u32x2*)(orow + 32 * q4 + 8 * g) = w; }
    } else {
#pragma unroll
        for (int q4 = 0; q4 < 4; ++q4)
#pragma unroll
            for (int g = 0; g < 4; ++g) { u32x2 v = {mla::cvtpk(O[q4][4 * g + 0], O[q4][4 * g + 1]), mla::cvtpk(O[q4][4 * g + 2], O[q4][4 * g + 3])}; *(u32x2*)(so + 32 * q4 + 8 * g) = v; }
        if (hi == 0) { sml[0] = m; sml[1] = lt; }
    }
#undef DIL_ISSUE
}
__device__ __forceinline__ void pass(LAS unsigned char* lds, const bf16* PROJ, const float* BIAS, float* DSO, float* DSML, bf16* MIX, int b) {
    for (int u = blockIdx.x; u < 512; u += gridDim.x) { const int h = u & 7, rest = u >> 3, d = 1 << (2 * b), r = rest & (d - 1), nb = rest >> (2 * b);
        unit(lds, PROJ, BIAS, DSO, DSML, MIX, b, r, h, nb); }
}
}
struct Args { const float* in[18]; float* out; unsigned char* ws; float inv[32]; int ph_lo, ph_hi; };
static_assert(sizeof(Args) == 18 * 8 + 8 + 8 + 32 * 4 + 8, "Args has no padding");

__device__ __forceinline__ void p0_prologue(const __attribute__((address_space(4))) Args* ap, LAS unsigned char* lds, int gw, int NGW, int wave, int lane) {
    const __attribute__((address_space(4))) Args& a = *ap;
    unsigned char* ws = a.ws;
    LAS float* scr = (LAS float*)(lds + RING_OFF + wave * 16384);
    constexpr int I_IN = 64 * 266, I_POOL = 4 * 4 * 8, I_UQ = 12 * 48, I_UKV = 8 * 64, I_OUT = 64 * 128, I_G = 64 * 344, I_DN = 172 * 128;
    constexpr int I_LAYER = I_IN + I_POOL + I_UQ + I_UKV + I_OUT + 2 * I_G + I_DN;
    constexpr int I_EARLY = I_IN + I_POOL + I_UQ + I_UKV;
    for (int it = gw; it < (MK_MLA_CONV ? I_EARLY : DEPTH * I_LAYER); it += NGW) {
        const int l = it / I_LAYER; int r = it - l * I_LAYER;
        unsigned char* wl = ws + WS_W + (size_t)l * W_LAYER;
        if (r < I_IN) { const int kb = r / 266, nb = r % 266; tr_item(a.in[1] + (size_t)l * DM * INW, INW, kb * 64, nb * 32, (bf16*)(wl + W_IN), DM, nb * 32, 1, nullptr, nullptr, scr, lane, DM / 64); continue; } r -= I_IN;
        if (r < I_POOL) { const int g = r / 32, q = r % 32, kb = q / 8, nb = q % 8;
            tr_item(a.in[2] + (size_t)(l * 4 + g) * 65536, 256, kb * 64, nb * 32, (bf16*)(wl + W_POOL), 256, g * 256 + nb * 32, 1, nullptr, a.in[3] + l * 1024 + g * 256, scr, lane, 256 / 64); continue; } r -= I_POOL;
        if (r < I_UQ) { const int kb = r / 48, nb = r % 48, n0 = nb * 32, h = n0 / 192, w = n0 % 192;
            const int orow0 = (w < 128) ? n0 : (h * 192 + 128 + (w == 128 ? 0 : 1)), ostr = (w < 128) ? 1 : 2;
            tr_item(a.in[7] + (size_t)l * QRANK * 1536, 1536, kb * 64, n0, (bf16*)(wl + W_UQ), QRANK, orow0, ostr, a.in[6] + l * QRANK, nullptr, scr, lane, QRANK / 64); continue; } r -= I_UQ;
        if (r < I_UKV) { const int kb = r / 64, nb = r % 64, n0 = nb * 32, h = n0 / 256, w = n0 % 256;
            bf16* dst = (bf16*)(wl + (w < 128 ? W_UK : W_UV));
            tr_item(a.in[9] + (size_t)l * KVRANK * 2048, 2048, kb * 64, n0, dst, KVRANK, h * 128 + (w & 127), 1, a.in[8] + l * KVRANK, nullptr, scr, lane, (w < 128 ? KVRANK / 64 : 0)); continue; } r -= I_UKV;
        if (r < I_OUT) { const int kb = r / 128, nb = r % 128; tr_item(a.in[10] + (size_t)l * DM * DM, DM, kb * 64, nb * 32, (bf16*)(wl + W_OUT), DM, nb * 32, 1, nullptr, nullptr, scr, lane, DM / 64); continue; } r -= I_OUT;
        if (r < 2 * I_G) { const int up = r >= I_G; if (up) r -= I_G; const int kb = r / 344, nb = r % 344, n0 = nb * 32;
            tr_item(a.in[up ? 14 : 13] + (size_t)l * DM * FFN, FFN, kb * 64, n0, (bf16*)(wl + W_GU), DM, (n0 >> 7) * 256 + (up ? 128 : 0) + (n0 & 127), 1, nullptr, nullptr, scr, lane, DM / 64); continue; } r -= 2 * I_G;
        { const int kb = r / 128, nb = r % 128; tr_item(a.in[15] + (size_t)l * FFN * DM, DM, kb * 64, nb * 32, (bf16*)(wl + W_DN), FFN, nb * 32, 1, nullptr, nullptr, scr, lane, FFN / 64); }
    }
    const int gt = gw * 64 + lane, NT = NGW * 64;
    for (int i = gt; i < DEPTH * 64 * 192 * 8; i += NT) { const int l = i / (64 * 192 * 8), r = i % (64 * 192 * 8), kt = r / (192 * 8), q = r % (192 * 8);
        *(v4u*)(ws + WS_W + (size_t)l * W_LAYER + W_IN + ((size_t)(33 * 64 + kt) * 256 + 64) * 128 + (size_t)q * 16) = (v4u){0u, 0u, 0u, 0u}; }
    for (int i = gt; i < M * DM / 8; i += NT) { const f32x4 v0 = *(const f32x4*)(a.in[0] + (size_t)i * 8), v1 = *(const f32x4*)(a.in[0] + (size_t)i * 8 + 4);
        v4u o; o.x = pk2(v0[0], v0[1]); o.y = pk2(v0[2], v0[3]); o.z = pk2(v1[0], v1[1]); o.w = pk2(v1[2], v1[3]); *(v4u*)(ws + WS_XB + (size_t)i * 16) = o; }
    for (int i = gt; i < M * 32; i += NT) { const int t = i >> 5, j = i & 31; const float ang = (float)t * a.inv[j]; float s, c; sincos_acc(ang, s, c);
        ((float*)(ws + WS_COS))[i] = c; ((float*)(ws + WS_SIN))[i] = s; }
    for (int i = gt; i < 3 * 129 * 8; i += NT) ((float*)(ws + WS_BIAS))[i] = a.in[4][(int)T5_BUCKET[i >> 3] * 8 + (i & 7)];
}

constexpr int CV_ITEMS_PER_LAYER = 64 * 266 + 4 * 4 * 8 + 12 * 48 + 8 * 64 + 64 * 128 + 2 * 64 * 344 + 172 * 128;
constexpr int CV_EARLY = 64 * 266 + 4 * 4 * 8 + 12 * 48 + 8 * 64, CV_LATE = CV_ITEMS_PER_LAYER - CV_EARLY;
struct CvDesc { const float* src; const float* gk; const float* gn; bf16* wt; int N, ldt, orow0, ostr, k0, nkt; };
__device__ __forceinline__ CvDesc cv_decode(const __attribute__((address_space(4))) Args& a, int l, int h2) {
    constexpr int I_IN = 64 * 266, I_POOL = 4 * 4 * 8, I_UQ = 12 * 48, I_UKV = 8 * 64, I_OUT = 64 * 128, I_G = 64 * 344;
    int r = h2 >> 1; const int kh = (h2 & 1) * 32; unsigned char* wl = a.ws + WS_W + (size_t)l * W_LAYER;
    const float* W; int N, k0, ns0, ldt, orow0, ostr = 1, tiled = 1; bf16* WT; const float* gk = nullptr; const float* gn = nullptr;
    if (r < I_IN) { const int kb = r / 266, nb = r % 266; W = a.in[1] + (size_t)l * DM * INW; N = INW; k0 = kb * 64; ns0 = nb * 32; WT = (bf16*)(wl + W_IN); ldt = DM; orow0 = nb * 32; }
    else if ((r -= I_IN) < I_POOL) { const int g = r / 32, q = r % 32, kb = q / 8, nb = q % 8; W = a.in[2] + (size_t)(l * 4 + g) * 65536; N = 256; k0 = kb * 64; ns0 = nb * 32; WT = (bf16*)(wl + W_POOL); ldt = 256; orow0 = g * 256 + nb * 32; gn = a.in[3] + l * 1024 + g * 256; }
    else if ((r -= I_POOL) < I_UQ) { const int kb = r / 48, nb = r % 48, n0 = nb * 32, h = n0 / 192, w = n0 % 192; W = a.in[7] + (size_t)l * QRANK * 1536; N = 1536; k0 = kb * 64; ns0 = n0; WT = (bf16*)(wl + W_UQ); ldt = QRANK;
        orow0 = (w < 128) ? n0 : (h * 192 + 128 + (w == 128 ? 0 : 1)); ostr = (w < 128) ? 1 : 2; gk = a.in[6] + l * QRANK; }
    else if ((r -= I_UQ) < I_UKV) { const int kb = r / 64, nb = r % 64, n0 = nb * 32, h = n0 / 256, w = n0 % 256; W = a.in[9] + (size_t)l * KVRANK * 2048; N = 2048; k0 = kb * 64; ns0 = n0; WT = (bf16*)(wl + (w < 128 ? W_UK : W_UV)); ldt = KVRANK; orow0 = h * 128 + (w & 127); gk = a.in[8] + l * KVRANK; tiled = (w < 128); }
    else if ((r -= I_UKV) < I_OUT) { const int kb = r / 128, nb = r % 128; W = a.in[10] + (size_t)l * DM * DM; N = DM; k0 = kb * 64; ns0 = nb * 32; WT = (bf16*)(wl + W_OUT); ldt = DM; orow0 = nb * 32; }
    else if ((r -= I_OUT) < 2 * I_G) { const int up = r >= I_G; if (up) r -= I_G; const int kb = r / 344, nb = r % 344, n0 = nb * 32; W = a.in[up ? 14 : 13] + (size_t)l * DM * FFN; N = FFN; k0 = kb * 64; ns0 = n0; WT = (bf16*)(wl + W_GU); ldt = DM; orow0 = (n0 >> 7) * 256 + (up ? 128 : 0) + (n0 & 127); }
    else { r -= 2 * I_G; const int kb = r / 128, nb = r % 128; W = a.in[15] + (size_t)l * FFN * DM; N = DM; k0 = kb * 64; ns0 = nb * 32; WT = (bf16*)(wl + W_DN); ldt = FFN; orow0 = nb * 32; }
    k0 += kh;
    CvDesc d; d.src = W + (size_t)k0 * N + ns0; d.gk = gk ? gk + k0 : nullptr; d.gn = gn ? gn + ns0 : nullptr; d.wt = WT; d.N = N; d.ldt = ldt; d.orow0 = orow0; d.ostr = ostr; d.k0 = k0; d.nkt = tiled ? ldt / 64 : 0; return d;
}
struct ConvBg {
    const __attribute__((address_space(4))) Args* ka; LAS unsigned char* slot; int lane, l, next, stride, end, pend;
    CvDesc cd;
    __device__ __forceinline__ void issue(int h2) { { const bool late = h2 < 2 * CV_LATE; cd = cv_decode(*ka, late ? l : l + 1, late ? h2 + 2 * CV_EARLY : h2 - 2 * CV_LATE); }
        unsigned vo = ((unsigned)(lane >> 3) * (unsigned)cd.N + 4u * (unsigned)(lane & 7)) * 4u;
#pragma unroll
        for (int i = 0; i < 4; ++i) { asm volatile("" : "+v"(vo)); __builtin_amdgcn_global_load_lds((const unsigned*)((const char*)(cd.src + (size_t)(8 * i) * cd.N) + vo), (LAS unsigned*)(slot + i * 1056), 16, 0, 0); } }
    __device__ __forceinline__ void finish() { const CvDesc d = cd; const int c = lane & 3; const LAS float* sf = (const LAS float*)slot;
        if (d.gk || d.gn) {
            f32x4 g0 = {1.f, 1.f, 1.f, 1.f}, g1 = g0; if (d.gk) { g0 = *(const f32x4*)(d.gk + 8 * c); g1 = *(const f32x4*)(d.gk + 8 * c + 4); }
#pragma unroll
            for (int j = 0; j < 2; ++j) { const int n = (lane >> 2) + 16 * j; const float gn = d.gn ? d.gn[n] : 1.f; const LAS float* s = sf + c * 264 + n;
                v4u o; o.x = mla::cvtpk(s[0] * g0[0] * gn, s[32] * g0[1] * gn); o.y = mla::cvtpk(s[64] * g0[2] * gn, s[96] * g0[3] * gn);
                o.z = mla::cvtpk(s[128] * g1[0] * gn, s[160] * g1[1] * gn); o.w = mla::cvtpk(s[192] * g1[2] * gn, s[224] * g1[3] * gn);
                *(v4u*)(d.wt + wt_off(d.orow0 + d.ostr * n, d.k0 + 8 * c, d.ldt, d.nkt)) = o; }
        } else {
            bf16* wb = d.wt + (((size_t)((d.orow0 >> 8) * d.nkt + (d.k0 >> 6)) * 256 + (d.orow0 & 255)) * 64 + (d.k0 & 63));
#pragma unroll
            for (int j = 0; j < 2; ++j) { const int n = (lane >> 2) + 16 * j; const LAS float* s = sf + c * 264 + n;
                v4u o; o.x = mla::cvtpk(s[0], s[32]); o.y = mla::cvtpk(s[64], s[96]); o.z = mla::cvtpk(s[128], s[160]); o.w = mla::cvtpk(s[192], s[224]);
                unsigned lo = (unsigned)(n * 64 + 8 * c) * 2u; asm volatile("" : "+v"(lo));
                *(v4u*)((char*)wb + lo) = o; }
        } }
    int nfly;
    __device__ __forceinline__ void pre(int j) { nfly = 0; if (j & 1) return; if (pend >= 0) { finish(); pend = -1; } asm volatile("s_waitcnt lgkmcnt(0)" ::: "memory"); }
    __device__ __forceinline__ void post(int j) { if (j & 1) return; if (next < end) { issue(next); pend = next; next += stride; nfly = 4; } }
    __device__ __forceinline__ void drain() {
        asm volatile("s_waitcnt vmcnt(0)" ::: "memory");
        if (pend >= 0) { finish(); pend = -1; }
        while (next < end) { asm volatile("s_waitcnt lgkmcnt(0)" ::: "memory"); issue(next); asm volatile("s_waitcnt vmcnt(0)" ::: "memory"); finish(); next += stride; }
    }
};

#define PREP_ACC8(S, V, SGN) do { S[0] += SGN bflo(V.x); S[1] += SGN bfhi(V.x); S[2] += SGN bflo(V.y); S[3] += SGN bfhi(V.y); S[4] += SGN bflo(V.z); S[5] += SGN bfhi(V.z); S[6] += SGN bflo(V.w); S[7] += SGN bfhi(V.w); } while (0)
template <int HH> __device__ __forceinline__ void prep_pool8(const bf16* PROJ, bf16* PD, int t0, int lane) {
    const int cg = lane + 64 * HH, col = cg * 8, w = 2 << (cg >> 5);
    const bf16* base = PROJ + (size_t)t0 * INWP + C_U + col;
    float s[8];
#pragma unroll
    for (int j = 0; j < 8; ++j) s[j] = 0.f;
    { constexpr int WMAX = HH ? 16 : 4; const int cnt = (t0 + 1 < w) ? t0 + 1 : w; v4u r[WMAX];
#pragma unroll
      for (int i = 0; i < WMAX; ++i) r[i] = (i < cnt) ? *(const v4u*)(base - (size_t)i * INWP) : (v4u){0u, 0u, 0u, 0u};
#pragma unroll
      for (int i = 0; i < WMAX; ++i) PREP_ACC8(s, r[i], +); }
    v4u un[8], uo[7];
    un[0] = *(const v4u*)base;
#pragma unroll
    for (int i = 1; i < 8; ++i) { un[i] = *(const v4u*)(base + (size_t)i * INWP); uo[i - 1] = (t0 + i - w >= 0) ? *(const v4u*)(base + (size_t)(i - w) * INWP) : (v4u){0u, 0u, 0u, 0u}; }
    v4u o[8];
#pragma unroll
    for (int i = 0; i < 8; ++i) { const int t = t0 + i;
        if (i > 0) { PREP_ACC8(s, un[i], +); PREP_ACC8(s, uo[i - 1], -); }
        const float ic = 1.0f / (float)((t + 1 < w) ? t + 1 : w); const v4u u = un[i];
        o[i].x = pk2(s[0] * ic - bflo(u.x), s[1] * ic - bfhi(u.x)); o[i].y = pk2(s[2] * ic - bflo(u.y), s[3] * ic - bfhi(u.y));
        o[i].z = pk2(s[4] * ic - bflo(u.z), s[5] * ic - bfhi(u.z)); o[i].w = pk2(s[6] * ic - bflo(u.w), s[7] * ic - bfhi(u.w)); }
    asm volatile("" ::: "memory");
#pragma unroll
    for (int i = 0; i < 8; ++i) *(v4u*)(PD + (size_t)(t0 + i) * 1024 + col) = o[i];
}
template <int HH> __device__ __forceinline__ void prep_conv8(const bf16* PROJ, bf16* MIX, const float* convw, int t0, int lane) {
    const int col = (lane + 64 * HH) * 8;
    f32x4 wt[3][2];
#pragma unroll
    for (int tap = 0; tap < 3; ++tap) { wt[tap][0] = *(const f32x4*)(convw + tap * 1024 + col); wt[tap][1] = *(const f32x4*)(convw + tap * 1024 + col + 4); }
    float zp[2][8];
#pragma unroll
    for (int q = 0; q < 2; ++q) { const int t = t0 - 2 + q;
        if (t >= 0) { const bf16* pr = PROJ + (size_t)t * INWP; const v4u hv = *(const v4u*)(pr + C_H + col), cv = *(const v4u*)(pr + C_C + col);
            zp[q][0] = bflo(cv.x) * bflo(hv.x); zp[q][1] = bfhi(cv.x) * bfhi(hv.x); zp[q][2] = bflo(cv.y) * bflo(hv.y); zp[q][3] = bfhi(cv.y) * bfhi(hv.y);
            zp[q][4] = bflo(cv.z) * bflo(hv.z); zp[q][5] = bfhi(cv.z) * bfhi(hv.z); zp[q][6] = bflo(cv.w) * bflo(hv.w); zp[q][7] = bfhi(cv.w) * bfhi(hv.w); }
        else {
#pragma unroll
            for (int j = 0; j < 8; ++j) zp[q][j] = 0.f; } }
#pragma unroll
    for (int half = 0; half < 2; ++half) {
        v4u hv[4], cv[4], bv[4], o[4];
#pragma unroll
        for (int i = 0; i < 4; ++i) { const bf16* pr = PROJ + (size_t)(t0 + 4 * half + i) * INWP; hv[i] = *(const v4u*)(pr + C_H + col); cv[i] = *(const v4u*)(pr + C_C + col); bv[i] = *(const v4u*)(pr + C_B + col); }
#pragma unroll
        for (int i = 0; i < 4; ++i) { float z[8], y[8];
            z[0] = bflo(cv[i].x) * bflo(hv[i].x); z[1] = bfhi(cv[i].x) * bfhi(hv[i].x); z[2] = bflo(cv[i].y) * bflo(hv[i].y); z[3] = bfhi(cv[i].y) * bfhi(hv[i].y);
            z[4] = bflo(cv[i].z) * bflo(hv[i].z); z[5] = bfhi(cv[i].z) * bfhi(hv[i].z); z[6] = bflo(cv[i].w) * bflo(hv[i].w); z[7] = bfhi(cv[i].w) * bfhi(hv[i].w);
#pragma unroll
            for (int j = 0; j < 8; ++j) { y[j] = wt[0][j >> 2][j & 3] * zp[0][j] + wt[1][j >> 2][j & 3] * zp[1][j] + wt[2][j >> 2][j & 3] * z[j]; zp[0][j] = zp[1][j]; zp[1][j] = z[j]; }
            o[i].x = pk2(bflo(bv[i].x) * y[0], bfhi(bv[i].x) * y[1]); o[i].y = pk2(bflo(bv[i].y) * y[2], bfhi(bv[i].y) * y[3]);
            o[i].z = pk2(bflo(bv[i].z) * y[4], bfhi(bv[i].z) * y[5]); o[i].w = pk2(bflo(bv[i].w) * y[6], bfhi(bv[i].w) * y[7]); }
        asm volatile("" ::: "memory");
        if (half == 0) {
        }
#pragma unroll
        for (int i = 0; i < 4; ++i) *(v4u*)(MIX + (size_t)(t0 + 4 * half + i) * DM + 2048 + col) = o[i];
    }
}
__device__ __forceinline__ float prep_sq8(v4u v) { return ((bflo(v.x) * bflo(v.x) + bfhi(v.x) * bfhi(v.x)) + (bflo(v.y) * bflo(v.y) + bfhi(v.y) * bfhi(v.y))) + ((bflo(v.z) * bflo(v.z) + bfhi(v.z) * bfhi(v.z)) + (bflo(v.w) * bflo(v.w) + bfhi(v.w) * bfhi(v.w))); }
__device__ __forceinline__ void prep_rms8(const bf16* PROJ, float* RQ, float* RKV, bf16* KR, const float* COS, const float* SIN, int t0, int lane) {
    v4u a[8], b[8], c[8]; float x1[8], x2[8], cs[8], sn[8]; const int j = lane & 31;
#pragma unroll
    for (int i = 0; i < 8; ++i) { const bf16* prow = PROJ + (size_t)(t0 + i) * INWP;
        a[i] = *(const v4u*)(prow + C_CQ + lane * 8); b[i] = (lane < 32) ? *(const v4u*)(prow + C_CQ + 512 + lane * 8) : (v4u){0u, 0u, 0u, 0u}; c[i] = *(const v4u*)(prow + C_CKV + lane * 8);
        x1[i] = bf2f(prow[C_KR + j]); x2[i] = bf2f(prow[C_KR + 32 + j]); cs[i] = COS[(size_t)(t0 + i) * 32 + j]; sn[i] = SIN[(size_t)(t0 + i) * 32 + j]; }
    float rq[8], rkv[8]; unsigned kr[8];
#pragma unroll
    for (int i = 0; i < 8; ++i) { rq[i] = 1.0f / sqrtf(wave_sum(prep_sq8(a[i]) + prep_sq8(b[i])) * (1.0f / QRANK) + RMS_EPS); rkv[i] = 1.0f / sqrtf(wave_sum(prep_sq8(c[i])) * (1.0f / KVRANK) + RMS_EPS);
        kr[i] = pk2(x1[i] * cs[i] - x2[i] * sn[i], x1[i] * sn[i] + x2[i] * cs[i]); }
    asm volatile("" ::: "memory");
#pragma unroll
    for (int i = 0; i < 8; ++i) { if (lane == 0) { RQ[t0 + i] = rq[i]; RKV[t0 + i] = rkv[i]; } if (lane < 32) *(unsigned*)(KR + (size_t)(t0 + i) * 64 + 2 * lane) = kr[i]; }
}
#undef PREP_ACC8
__device__ __forceinline__ void prep8(const bf16* PROJ, bf16* PD, bf16* MIX, float* RQ, float* RKV, bf16* KR, const float* COS, const float* SIN, const float* convw, int t0, int lane) {
    prep_pool8<0>(PROJ, PD, t0, lane); asm volatile("" ::: "memory");
    prep_pool8<1>(PROJ, PD, t0, lane); asm volatile("" ::: "memory");
    prep_conv8<0>(PROJ, MIX, convw, t0, lane); asm volatile("" ::: "memory");
    prep_conv8<1>(PROJ, MIX, convw, t0, lane); asm volatile("" ::: "memory");
    prep_rms8(PROJ, RQ, RKV, KR, COS, SIN, t0, lane);
}

template <bool IN32, bool OUT32, bool RDLO = true, bool WRLO = true>
__device__ __forceinline__ void ln_phase(const float* xin32, const bf16* YB, float* XOUT32, bf16* XB, unsigned* XL, const float* g, const float* b, LAS unsigned char* lds, int gw, int NGW, int lane, int tid) {
    LAS f32x4* gl = (LAS f32x4*)lds; LAS f32x4* bl = gl + 1024;
    for (int i = tid; i < 1024; i += NWAVES * 64) { gl[i] = *(const f32x4*)(g + 4 * i); bl[i] = *(const f32x4*)(b + 4 * i); }
    __syncthreads();
    typedef float f32x2_t __attribute__((ext_vector_type(2)));
    f32x4 xr[IN32 ? 16 : 1]; unsigned long long xh[IN32 ? 1 : 16]; unsigned xl[IN32 ? 1 : 16]; unsigned long long yr[16];
#define LN_LOAD(mm) do { _Pragma("unroll") for (int j = 0; j < 16; ++j) { const size_t o_ = (size_t)(mm) * DM + 4 * lane + 256 * j; \
            if (IN32) xr[IN32 ? j : 0] = *(const f32x4*)(xin32 + o_); else { xh[IN32 ? 0 : j] = *(const unsigned long long*)(XB + o_); if (RDLO) xl[IN32 ? 0 : j] = XL[o_ >> 2]; } \
            yr[j] = *(const unsigned long long*)(YB + o_); } } while (0)
    int m = gw;
    if (m < M) LN_LOAD(m);
    for (; m < M; m += NGW) {
        f32x4 v[16]; float s = 0.f;
#pragma unroll
        for (int j = 0; j < 16; ++j) { const unsigned y0 = (unsigned)yr[j], y1 = (unsigned)(yr[j] >> 32); f32x4 x;
            if (IN32) x = xr[IN32 ? j : 0];
            else { const unsigned h0 = (unsigned)xh[IN32 ? 0 : j], h1 = (unsigned)(xh[IN32 ? 0 : j] >> 32); const int lw = RDLO ? (int)xl[IN32 ? 0 : j] : 0;
                const f32x2_t l01 = __builtin_amdgcn_cvt_pk_f32_fp8(lw, false), l23 = __builtin_amdgcn_cvt_pk_f32_fp8(lw, true);
                x[0] = bflo(h0) + l01.x * (1.0f / 512.0f); x[1] = bfhi(h0) + l01.y * (1.0f / 512.0f); x[2] = bflo(h1) + l23.x * (1.0f / 512.0f); x[3] = bfhi(h1) + l23.y * (1.0f / 512.0f); }
            v[j][0] = x[0] * ALPHA + bflo(y0); v[j][1] = x[1] * ALPHA + bfhi(y0); v[j][2] = x[2] * ALPHA + bflo(y1); v[j][3] = x[3] * ALPHA + bfhi(y1);
            s += (v[j][0] + v[j][1]) + (v[j][2] + v[j][3]); }
        asm volatile("" ::: "memory");
        const int mn = m + NGW;
        if (mn < M) LN_LOAD(mn);
        asm volatile("" ::: "memory");
        const float mean = wave_sum(s) * (1.0f / DM); float s2 = 0.f;
#pragma unroll
        for (int j = 0; j < 16; ++j) { v[j] = v[j] - mean; s2 += (v[j][0] * v[j][0] + v[j][1] * v[j][1]) + (v[j][2] * v[j][2] + v[j][3] * v[j][3]); }
        const float rstd = 1.0f / sqrtf(wave_sum(s2) * (1.0f / DM) + LN_EPS);
#pragma unroll
        for (int j = 0; j < 16; ++j) { const f32x4 gg = gl[lane + 64 * j], bb = bl[lane + 64 * j]; const size_t o = (size_t)m * DM + 4 * lane + 256 * j;
            const f32x4 y = v[j] * rstd * gg + bb;
            if (OUT32) *(f32x4*)(XOUT32 + o) = y;
            else { const unsigned h0 = pk2(y[0], y[1]), h1 = pk2(y[2], y[3]);
                int lw = 0; lw = __builtin_amdgcn_cvt_pk_fp8_f32((y[0] - bflo(h0)) * 512.0f, (y[1] - bfhi(h0)) * 512.0f, lw, false); lw = __builtin_amdgcn_cvt_pk_fp8_f32((y[2] - bflo(h1)) * 512.0f, (y[3] - bfhi(h1)) * 512.0f, lw, true);
                *(unsigned long long*)(XB + o) = (unsigned long long)h0 | ((unsigned long long)h1 << 32); if (WRLO) XL[o >> 2] = (unsigned)lw; }
            if ((j & 3) == 3) asm volatile("" ::: "memory"); }
    }
#undef LN_LOAD
}

__device__ __forceinline__ void dil_naive_item(const bf16* PROJ, const float* BIAS, bf16* MIX, int t, int h, LAS float* qs, int lane) {
    const bf16* prow = PROJ + (size_t)t * INWP;
    { const unsigned qq = *(const unsigned*)(prow + C_Q + h * 128 + 2 * lane); qs[2 * lane] = bflo(qq); qs[2 * lane + 1] = bfhi(qq); }
    LDS_WAIT(); asm volatile("" ::: "memory");
    float lg[3][3]; float mx = -__builtin_inff();
#pragma unroll
    for (int b = 0; b < 3; ++b)
#pragma unroll
        for (int ps = 0; ps < 3; ++ps) { const int d = 1 << (2 * b), s = lane + 64 * ps, kp = t - s * d; float v = -__builtin_inff();
            if (s <= 128 && kp >= 0) { const bf16* kr = PROJ + (size_t)kp * INWP + C_K + h * 128; float dot = 0.f;
#pragma unroll
                for (int c = 0; c < 16; ++c) { const v4u kv = *(const v4u*)(kr + 8 * c); const f32x4 q0 = *(const LAS f32x4*)(qs + 8 * c), q1 = *(const LAS f32x4*)(qs + 8 * c + 4);
                    dot += bflo(kv.x) * q0[0] + bfhi(kv.x) * q0[1] + bflo(kv.y) * q0[2] + bfhi(kv.y) * q0[3] + bflo(kv.z) * q1[0] + bfhi(kv.z) * q1[1] + bflo(kv.w) * q1[2] + bfhi(kv.w) * q1[3]; }
                v = dot * DIL_SCALE + BIAS[(b * 129 + s) * 8 + h]; }
            lg[b][ps] = v; mx = fmaxf(mx, v); }
    mx = wave_max(mx);
    float den = 0.f;
#pragma unroll
    for (int b = 0; b < 3; ++b)
#pragma unroll
        for (int ps = 0; ps < 3; ++ps) { lg[b][ps] = __expf(lg[b][ps] - mx); den += lg[b][ps]; }
    den = wave_sum(den);
    float o0 = 0.f, o1 = 0.f;
#pragma unroll
    for (int b = 0; b < 3; ++b)
#pragma unroll
        for (int ps = 0; ps < 3; ++ps) { const int d = 1 << (2 * b); const int nl = (ps == 2) ? 1 : 64;
            for (int i = 0; i < nl; ++i) { const int s = i + 64 * ps, kp = t - s * d; if (kp < 0) break;
                const float p = __shfl(lg[b][ps], i); const unsigned vv = *(const unsigned*)(PROJ + (size_t)kp * INWP + C_V + h * 128 + 2 * lane);
                o0 += p * bflo(vv); o1 += p * bfhi(vv); } }
    const float id = 1.0f / den;
    *(unsigned*)(MIX + (size_t)t * DM + 1024 + h * 128 + 2 * lane) = pk2(o0 * id, o1 * id);
    LDS_WAIT(); asm volatile("" ::: "memory");
}

__device__ __forceinline__ void mla_naive_item(const bf16* Q, const bf16* KN, const bf16* KR, const bf16* VT, bf16* MIX, int t, int h, LAS float* qs, int lane) {
    { const bf16* qrow = Q + (size_t)t * 1536 + h * 192; qs[lane] = bf2f(qrow[lane]); qs[lane + 64] = bf2f(qrow[lane + 64]); qs[lane + 128] = bf2f(qrow[lane + 128]); }
    LDS_WAIT(); asm volatile("" ::: "memory");
    float acc[128];
#pragma unroll
    for (int i = 0; i < 128; ++i) acc[i] = 0.f;
    float mrun = -1e30f, lrun = 0.f;
    for (int k0 = 0; k0 <= t; k0 += 64) {
        const int key = k0 + lane; const bool valid = key <= t; float s = -__builtin_inff();
        if (valid) { const bf16* kn = KN + (size_t)key * 1024 + h * 128; const bf16* kr = KR + (size_t)key * 64; float dot = 0.f;
#pragma unroll
            for (int c = 0; c < 16; ++c) { const v4u kv = *(const v4u*)(kn + 8 * c); const f32x4 q0 = *(const LAS f32x4*)(qs + 8 * c), q1 = *(const LAS f32x4*)(qs + 8 * c + 4);
                dot += bflo(kv.x) * q0[0] + bfhi(kv.x) * q0[1] + bflo(kv.y) * q0[2] + bfhi(kv.y) * q0[3] + bflo(kv.z) * q1[0] + bfhi(kv.z) * q1[1] + bflo(kv.w) * q1[2] + bfhi(kv.w) * q1[3]; }
#pragma unroll
            for (int c = 0; c < 8; ++c) { const v4u kv = *(const v4u*)(kr + 8 * c); const f32x4 q0 = *(const LAS f32x4*)(qs + 128 + 8 * c), q1 = *(const LAS f32x4*)(qs + 128 + 8 * c + 4);
                dot += bflo(kv.x) * q0[0] + bfhi(kv.x) * q0[1] + bflo(kv.y) * q0[2] + bfhi(kv.y) * q0[3] + bflo(kv.z) * q1[0] + bfhi(kv.z) * q1[1] + bflo(kv.w) * q1[2] + bfhi(kv.w) * q1[3]; }
            s = dot; }
        const float mnew = fmaxf(mrun, wave_max(s)); const float alpha = __builtin_amdgcn_exp2f(mrun - mnew); const float p = valid ? __builtin_amdgcn_exp2f(s - mnew) : 0.f;
        lrun = lrun * alpha + wave_sum(p); mrun = mnew;
        const bf16* vp = VT + (size_t)(h * 128) * M + (valid ? key : 0);
#pragma unroll
        for (int dv = 0; dv < 128; ++dv) acc[dv] = acc[dv] * alpha + p * bf2f(vp[(size_t)dv * M]);
    }
    float o0 = 0.f, o1 = 0.f;
#pragma unroll
    for (int dv = 0; dv < 128; ++dv) { const float r = wave_sum(acc[dv]); if (lane == (dv & 63)) { if (dv < 64) o0 = r; else o1 = r; } }
    const float il = 1.0f / lrun;
    MIX[(size_t)t * DM + 3072 + h * 128 + lane] = (bf16)f2bf(o0 * il); MIX[(size_t)t * DM + 3072 + h * 128 + 64 + lane] = (bf16)f2bf(o1 * il);
    LDS_WAIT(); asm volatile("" ::: "memory");
}

typedef const __attribute__((address_space(4))) Args* KArgs;
__device__ __forceinline__ KArgs kargs() { KArgs p = (KArgs)__builtin_amdgcn_kernarg_segment_ptr(); asm volatile("" : "+s"(p)); return p; }
#define PHASE_IDS() int tid_ = threadIdx.x; asm volatile("" : "+v"(tid_)); const int lane = tid_ & 63, wave = __builtin_amdgcn_readfirstlane(tid_ >> 6); \
    const int G = gridDim.x, bx = blockIdx.x, vcu = (G % 8 == 0) ? (bx % 8) * (G / 8) + bx / 8 : bx, gw = vcu * NWAVES + wave, NGW = G * NWAVES; (void)lane; (void)gw; (void)NGW; (void)bx
__global__ void __launch_bounds__(NWAVES * 64, 2) fwd(Args args_unused) {
    extern __shared__ __attribute__((aligned(16))) unsigned char lds_raw[];
    LAS unsigned char* lds = (LAS unsigned char*)lds_raw;
    for (int u = threadIdx.x; u < (LDS_BYTES - LDSCTL_OFF) / 4; u += NWAVES * 64) ((LAS unsigned*)(lds + LDSCTL_OFF))[u] = 0u;
    __syncthreads();
    int lo, hi;
    { KArgs ka = kargs(); lo = ka->ph_lo; hi = ka->ph_hi; }
#if MK_ONE_LAUNCH
    XcdBarrier bar; { KArgs ka = kargs(); bar = xcd_barrier_post((unsigned*)(ka->ws + WS_CTL) + CW_BAR, (volatile LAS unsigned*)(lds + MISC_OFF) + 8); }
#ifdef MK_BAR_TWICE
#define SEAM(k) do { if (IN(k) && IN((k) + 1)) { xcd_barrier(bar); xcd_barrier(bar); } } while (0)
#else
#define SEAM(k) do { if (IN(k) && IN((k) + 1)) xcd_barrier(bar); } while (0)
#endif
#else
#define SEAM(k) do { } while (0)
#endif
#ifndef MK_PHMASK
#define MK_PHMASK 0x3ff
#endif
#define IN(k) (lo <= (k) && (k) < hi)
#define EN(b) (((MK_PHMASK) >> (b)) & 1)
#ifndef MK_REPEAT
#define MK_REPEAT 0
#endif
#define NREP(b) ((((MK_REPEAT) >> (b)) & 1) ? 2 : 1)

    if (EN(9) && IN(0)) { for (int rep = 0; rep < NREP(9); ++rep) { PHASE_IDS(); p0_prologue(kargs(), lds, gw, NGW, wave, lane); } SEAM(0); }

    for (int l = 0; l < DEPTH; ++l) {
        const int p0 = 1 + l * NPH;
        if (EN(0) && IN(p0 + 0)) {
            KArgs ka = kargs(); unsigned char* ws = ka->ws; unsigned char* wl = ws + WS_W + (size_t)l * W_LAYER;
            pg8::Gemm g{(const bf16*)(ws + WS_XB), (const bf16*)(wl + W_IN), M, INWP, DM, DM, 0, 0}; pg8::StaticOrder S; S.init(M, INWP, gridDim.x, blockIdx.x);
            pg8::EpiBf16 E{(bf16*)(ws + WS_PROJ), INWP, nullptr};
            for (int rep = 0; rep < NREP(0); ++rep) pg8::gemm_phase<pg8::EpiBf16, pg8::StaticOrder>(lds + RING_OFF, g, S, E);
            SEAM(p0 + 0);
        }
        if (EN(1) && IN(p0 + 1)) {
#if !MK_NAIVE_DIL
            { KArgs ka = kargs(); unsigned char* ws = ka->ws; dil::pass(lds + RING_OFF, (const bf16*)(ws + WS_PROJ), (const float*)(ws + WS_BIAS), (float*)(ws + WS_DSO), (float*)(ws + WS_DSML), (bf16*)(ws + WS_MIX), 0); if (NREP(5) == 2) dil::pass(lds + RING_OFF, (const bf16*)(ws + WS_PROJ), (const float*)(ws + WS_BIAS), (float*)(ws + WS_DSO), (float*)(ws + WS_DSML), (bf16*)(ws + WS_MIX), 0); }
#endif
            PHASE_IDS(); KArgs ka = kargs(); unsigned char* ws = ka->ws;
            const float* convw = ka->in[5] + (size_t)l * 3 * 1024;
            for (int rep = 0; rep < NREP(1); ++rep)
            for (int tb = gw; tb < M / 8; tb += NGW)
                prep8((const bf16*)(ws + WS_PROJ), (bf16*)(ws + WS_PD), (bf16*)(ws + WS_MIX), (float*)(ws + WS_RQ), (float*)(ws + WS_RKV), (bf16*)(ws + WS_KR), (const float*)(ws + WS_COS), (const float*)(ws + WS_SIN), convw, tb * 8, lane);
            SEAM(p0 + 1);
        }
        if (EN(2) && IN(p0 + 2)) {
#if !MK_NAIVE_DIL
            { KArgs ka = kargs(); unsigned char* ws = ka->ws; dil::pass(lds + RING_OFF, (const bf16*)(ws + WS_PROJ), (const float*)(ws + WS_BIAS), (float*)(ws + WS_DSO), (float*)(ws + WS_DSML), (bf16*)(ws + WS_MIX), 1); }
#endif
            for (int rep = 0; rep < NREP(2); ++rep) {
            { KArgs ka = kargs(); unsigned char* ws = ka->ws; unsigned char* wl = ws + WS_W + (size_t)l * W_LAYER;
              pg8::Gemm g{(const bf16*)(ws + WS_PD), (const bf16*)(wl + W_POOL), M, 1024, 256, 1024, 0, 512}; pg8::StaticOrder S; S.init(M, 1024, gridDim.x, blockIdx.x);
              pg8::EpiBf16 E{(bf16*)(ws + WS_MIX), DM, nullptr};
              pg8::gemm_phase<pg8::EpiBf16, pg8::StaticOrder>(lds + RING_OFF, g, S, E); }
            { KArgs ka = kargs(); unsigned char* ws = ka->ws; unsigned char* wl = ws + WS_W + (size_t)l * W_LAYER;
              pg8::Gemm g{(const bf16*)(ws + WS_PROJ) + C_CQ, (const bf16*)(wl + W_UQ), M, 1536, QRANK, INWP, 0, 0}; pg8::StaticOrder S; S.init(M, 1536, gridDim.x, blockIdx.x);
              pg8::EpiQRope E{(bf16*)(ws + WS_Q), (const float*)(ws + WS_RQ), (const float*)(ws + WS_COS), (const float*)(ws + WS_SIN), QSCALE};
              pg8::gemm_phase<pg8::EpiQRope, pg8::StaticOrder>(lds + RING_OFF, g, S, E); }
            { KArgs ka = kargs(); unsigned char* ws = ka->ws; unsigned char* wl = ws + WS_W + (size_t)l * W_LAYER;
              pg8::Gemm g{(const bf16*)(ws + WS_PROJ) + C_CKV, (const bf16*)(wl + W_UK), M, 1024, KVRANK, INWP, 0, 0}; pg8::StaticOrder S; S.init(M, 1024, gridDim.x, blockIdx.x);
              pg8::EpiBf16 E{(bf16*)(ws + WS_KN), 1024, (const float*)(ws + WS_RKV)};
              pg8::gemm_phase<pg8::EpiBf16, pg8::StaticOrder>(lds + RING_OFF, g, S, E); }
            { KArgs ka = kargs(); unsigned char* ws = ka->ws; unsigned char* wl = ws + WS_W + (size_t)l * W_LAYER;
              pg8::Gemm g{(const bf16*)(wl + W_UV), (const bf16*)(ws + WS_PROJ) + C_CKV, 1024, M, KVRANK, KVRANK, INWP, 0}; pg8::StaticOrder S; S.init(1024, M, gridDim.x, blockIdx.x);
              pg8::EpiBf16ColScale E{(bf16*)(ws + WS_VT), M, (const float*)(ws + WS_RKV)};
              pg8::gemm_phase<pg8::EpiBf16ColScale, pg8::StaticOrder>(lds + RING_OFF, g, S, E); }
            }
            SEAM(p0 + 2);
        }
        if (EN(3) && IN(p0 + 3)) {
#if !MK_NAIVE_DIL
            { KArgs ka = kargs(); unsigned char* ws = ka->ws; dil::pass(lds + RING_OFF, (const bf16*)(ws + WS_PROJ), (const float*)(ws + WS_BIAS), (float*)(ws + WS_DSO), (float*)(ws + WS_DSML), (bf16*)(ws + WS_MIX), 2); }
#else
            { PHASE_IDS(); KArgs ka = kargs(); unsigned char* ws = ka->ws; LAS float* qs = (LAS float*)(lds + RING_OFF + wave * 1024);
              for (int it = gw; it < M * NHEAD; it += NGW) dil_naive_item((const bf16*)(ws + WS_PROJ), (const float*)(ws + WS_BIAS), (bf16*)(ws + WS_MIX), it >> 3, it & 7, qs, lane); }
#endif
#if MK_NAIVE_MLA
            { PHASE_IDS(); KArgs ka = kargs(); unsigned char* ws = ka->ws; LAS float* qs = (LAS float*)(lds + RING_OFF + wave * 1024);
              for (int it = gw; it < M * NHEAD; it += NGW) mla_naive_item((const bf16*)(ws + WS_Q), (const bf16*)(ws + WS_KN), (const bf16*)(ws + WS_KR), (const bf16*)(ws + WS_VT), (bf16*)(ws + WS_MIX), it >> 3, it & 7, qs, lane); }
#else
            { __syncthreads();
              PHASE_IDS(); ConvBg bg; bg.ka = kargs(); bg.slot = lds + (wave < 3 ? mla::AB_LDS_BYTES + wave * 4224 : BGSLOT_HI + (wave - 3) * 4224); bg.lane = lane; bg.l = l; bg.next = gw; bg.stride = NGW; bg.pend = -1; bg.nfly = 0;
              bg.end = MK_MLA_CONV ? 2 * (CV_LATE + (l + 1 < DEPTH ? CV_EARLY : 0)) : 0;
              for (int i = blockIdx.x; i < 256; i += gridDim.x) {
                KArgs ka = kargs(); unsigned char* ws = ka->ws; const int h = i & 7, x = i >> 3;
                mla::unit_ab(lds + RING_OFF, (const bf16*)(ws + WS_Q), (const bf16*)(ws + WS_KN), (const bf16*)(ws + WS_KR), (const bf16*)(ws + WS_VT), (bf16*)(ws + WS_MIX), h, 63 - x, bg);
                mla::unit_ab(lds + RING_OFF, (const bf16*)(ws + WS_Q), (const bf16*)(ws + WS_KN), (const bf16*)(ws + WS_KR), (const bf16*)(ws + WS_VT), (bf16*)(ws + WS_MIX), h, x, bg); }
              bg.drain(); }
#endif
            SEAM(p0 + 3);
        }
        if (EN(4) && IN(p0 + 4)) {
            KArgs ka = kargs(); unsigned char* ws = ka->ws; unsigned char* wl = ws + WS_W + (size_t)l * W_LAYER;
            pg8::Gemm g{(const bf16*)(ws + WS_MIX), (const bf16*)(wl + W_OUT), M, DM, DM, DM, 0, 0}; pg8::StaticOrder S; S.init(M, DM, gridDim.x, blockIdx.x);
            pg8::EpiBf16 E{(bf16*)(ws + WS_YB), DM, nullptr};
            for (int rep = 0; rep < NREP(4); ++rep) pg8::gemm_phase<pg8::EpiBf16, pg8::StaticOrder>(lds + RING_OFF, g, S, E);
            SEAM(p0 + 4);
        }
        if (EN(5) && IN(p0 + 5)) {
            PHASE_IDS(); KArgs ka = kargs(); unsigned char* ws = ka->ws; float* XF = ka->out; const float* xin = (l == 0) ? ka->in[0] : (const float*)XF; bf16* XB = (bf16*)(ws + WS_XB); const bf16* YB = (const bf16*)(ws + WS_YB);
            const float* gg = ka->in[11] + (size_t)l * DM; const float* bb = ka->in[12] + (size_t)l * DM;
            unsigned* XL = (unsigned*)(ws + WS_XL);
            if (l == 0) ln_phase<true, false, false, XL_LN1>(xin, YB, XF, XB, XL, gg, bb, lds + RING_OFF, gw, NGW, lane, tid_);
            else ln_phase<false, false, XL_LN2, XL_LN1>(xin, YB, XF, XB, XL, gg, bb, lds + RING_OFF, gw, NGW, lane, tid_);
            SEAM(p0 + 5);
        }
        if (EN(6) && IN(p0 + 6)) {
            KArgs ka = kargs(); unsigned char* ws = ka->ws; unsigned char* wl = ws + WS_W + (size_t)l * W_LAYER;
            pg8::Gemm g{(const bf16*)(ws + WS_XB), (const bf16*)(wl + W_GU), M, 2 * FFN, DM, DM, 0, 0}; pg8::StaticOrder S; S.init(M, 2 * FFN, gridDim.x, blockIdx.x);
            pg8::EpiSwiGLU E{(bf16*)(ws + WS_HID), FFN};
            for (int rep = 0; rep < NREP(6); ++rep) pg8::gemm_phase<pg8::EpiSwiGLU, pg8::StaticOrder>(lds + RING_OFF, g, S, E);
            SEAM(p0 + 6);
        }
        if (EN(7) && IN(p0 + 7)) {
            KArgs ka = kargs(); unsigned char* ws = ka->ws; unsigned char* wl = ws + WS_W + (size_t)l * W_LAYER;
            pg8::Gemm g{(const bf16*)(ws + WS_HID), (const bf16*)(wl + W_DN), M, DM, FFN, FFN, 0, 0}; pg8::StaticOrder S; S.init(M, DM, gridDim.x, blockIdx.x);
            pg8::EpiBf16 E{(bf16*)(ws + WS_YB), DM, nullptr};
            for (int rep = 0; rep < NREP(7); ++rep) pg8::gemm_phase<pg8::EpiBf16, pg8::StaticOrder>(lds + RING_OFF, g, S, E);
            SEAM(p0 + 7);
        }
        if (EN(8) && IN(p0 + 8)) {
            PHASE_IDS(); KArgs ka = kargs(); unsigned char* ws = ka->ws; float* XF = ka->out; bf16* XB = (bf16*)(ws + WS_XB); const bf16* YB = (const bf16*)(ws + WS_YB);
            const float* gg = ka->in[16] + (size_t)l * DM; const float* bb = ka->in[17] + (size_t)l * DM;
            unsigned* XL = (unsigned*)(ws + WS_XL);
            if (l == DEPTH - 1) ln_phase<false, true, XL_LN1, false>(XF, YB, XF, XB, XL, gg, bb, lds + RING_OFF, gw, NGW, lane, tid_);
            else ln_phase<false, false, XL_LN1, XL_LN2>(XF, YB, XF, XB, XL, gg, bb, lds + RING_OFF, gw, NGW, lane, tid_);
            SEAM(p0 + 8);
        }
    }
#undef IN
#undef SEAM
#undef EN
}

extern "C" void kernel_launch(void* const* d_in, const int* in_sizes, int n_in, void* d_out, int out_size, void* d_ws, size_t ws_size, hipStream_t stream) {
    static int grid = 0;
    if (grid == 0) {
        if (n_in != 18 || in_sizes[0] != M * DM || out_size != M * DM || ws_size < WS_END) { fprintf(stderr, "kernel_launch: unexpected shapes (n_in %d, in0 %d, out %d, ws %zu < %zu); nothing launched\n", n_in, n_in > 0 ? in_sizes[0] : -1, out_size, ws_size, (size_t)WS_END); grid = -1; return; }
        int dev = 0, cus = 0, per_cu = 0;
        if (hipGetDevice(&dev) != hipSuccess || hipDeviceGetAttribute(&cus, hipDeviceAttributeMultiprocessorCount, dev) != hipSuccess) { fprintf(stderr, "kernel_launch: device query failed\n"); grid = -1; return; }
        if (hipFuncSetAttribute((const void*)fwd, hipFuncAttributeMaxDynamicSharedMemorySize, LDS_BYTES) != hipSuccess) { fprintf(stderr, "kernel_launch: hipFuncSetAttribute failed\n"); grid = -1; return; }
        if (hipOccupancyMaxActiveBlocksPerMultiprocessor(&per_cu, (const void*)fwd, NWAVES * 64, LDS_BYTES) != hipSuccess || per_cu < 1) { fprintf(stderr, "kernel_launch: occupancy query reports %d workgroups per CU\n", per_cu); }
        (void)hipGetLastError();
        grid = cus;
    }
    if (grid < 0) return;
    if (hipMemsetAsync((char*)d_ws + WS_CTL, 0, CTL_ZERO_BYTES, stream) != hipSuccess) { fprintf(stderr, "kernel_launch: memset failed\n"); return; }
    Args a{};
    for (int i = 0; i < 18; ++i) a.in[i] = (const float*)d_in[i];
    a.out = (float*)d_out; a.ws = (unsigned char*)d_ws;
    for (int j = 0; j < 32; ++j) a.inv[j] = (float)pow(10000.0, -(double)(2 * j) / 64.0);
#if MK_ONE_LAUNCH
    a.ph_lo = 0; a.ph_hi = NPHASES;
    hipLaunchKernelGGL(fwd, dim3(grid), dim3(NWAVES * 64), LDS_BYTES, stream, a);
#else
    for (int p = 0; p < NPHASES; ++p) { a.ph_lo = p; a.ph_hi = p + 1; hipLaunchKernelGGL(fwd, dim3(grid), dim3(NWAVES * 64), LDS_BYTES, stream, a); }
#endif
    const hipError_t le = hipPeekAtLastError();
    if (le != hipSuccess) fprintf(stderr, "kernel_launch: launch failed: %s\n", hipGetErrorName(le));
}
```

```cpp
#include <hip/hip_runtime.h>
#include <cstdio>
#include <cstdint>
#include <cmath>
namespace pg8 {
#define PG8_LAS __attribute__((address_space(3)))
typedef unsigned short bf16_t;
typedef short bf16x8 __attribute__((ext_vector_type(8)));
typedef float f32x4 __attribute__((ext_vector_type(4)));
typedef unsigned u32x4 __attribute__((ext_vector_type(4)));
constexpr int BM = 256, BK = 64, HALF = 128, HTB = HALF * BK * 2  , STAGE_BYTES = 8 * HTB, NXCD = 8, WGM = 8;

__host__ __device__ __forceinline__ int lds_byte(int r, int c) { const int st = (r >> 4) * 2 + (c >> 5), rr = r & 15, cc = c & 31, ob = rr * 64 + cc * 2; return st * 1024 + (ob ^ (((ob >> 9) & 1) << 5)); }
__host__ __device__ __forceinline__ void stage_rc(int b, int& R, int& C) { const int st = b / 1024, sb = b % 1024, swz = sb ^ (((sb >> 9) & 1) << 5); R = (st >> 1) * 16 + swz / 64; C = (st & 1) * 32 + (swz % 64) / 2; }
__host__ __device__ __forceinline__ int perm32(int rho) { const int n = rho >> 4, i = rho & 15; return 8 * (i >> 2) + 4 * n + (i & 3); }

struct Unit { int pm, pn; };
struct Gemm { const bf16_t* A; const bf16_t* Bt; int M, N, K, lda, ldb, acs; };

struct StaticOrder {
    int nM, nN, nwg, G, c;
    __host__ __device__ void init(int M, int N, int G_, int c_) { nM = M / BM; nN = N / BM; nwg = nM * nN; G = G_; c = c_; }
    __host__ __device__ bool next(int i, Unit& u) const {
        const long L = (long)i * G + c; if (L >= nwg) return false;
        int wgid = (int)L; { const int q = nwg / NXCD, r = nwg % NXCD, xcd = wgid % NXCD, off = wgid / NXCD; wgid = (xcd < r ? xcd * (q + 1) : r * (q + 1) + (xcd - r) * q) + off; }
        const int nig = WGM * nN, gid = wgid / nig, fm = gid * WGM, gsz = (nM - fm) < WGM ? (nM - fm) : WGM;
        u.pm = fm + ((wgid % nig) % gsz); u.pn = (wgid % nig) / gsz; return true;
    }
    __device__ __forceinline__ void a_ready(const Unit&) const {}
    __device__ __forceinline__ void done(const Unit&) const {}
};

__device__ __forceinline__ unsigned cvt_pk_bf16(float lo, float hi) { unsigned r; asm volatile("v_cvt_pk_bf16_f32 %0, %1, %2" : "=v"(r) : "v"(lo), "v"(hi)); return r; }

struct EpiBf16 {
    static constexpr bool PERM = true;
    bf16_t* O; int ldc; const float* rs;
    __device__ __forceinline__ void operator()(const f32x4 (&acc)[2][2][4][2], const Unit& u, int wr, int wc, int fr, int fq) const {
        const int row0 = u.pm * BM + wr * 64 + fr, col0 = u.pn * BM + wc * 32 + 8 * fq;
#pragma unroll
        for (int ai = 0; ai < 2; ++ai)
#pragma unroll
            for (int m = 0; m < 4; ++m) { const int row = row0 + ai * HALF + m * 16; const float s = rs ? rs[row] : 1.f; bf16_t* rowp = O + (size_t)row * ldc + col0;
#pragma unroll
                for (int bj = 0; bj < 2; ++bj) { const f32x4 v0 = acc[ai][bj][m][0] * s, v1 = acc[ai][bj][m][1] * s;
                    u32x4 w; w.x = cvt_pk_bf16(v0[0], v0[1]); w.y = cvt_pk_bf16(v0[2], v0[3]); w.z = cvt_pk_bf16(v1[0], v1[1]); w.w = cvt_pk_bf16(v1[2], v1[3]);
                    *(u32x4*)(rowp + bj * HALF) = w; } }
    }
};
struct EpiQRope {
    static constexpr bool PERM = true;
    bf16_t* Q; const float* rq; const float* cs; const float* sn; float qs;
    __device__ __forceinline__ void operator()(const f32x4 (&acc)[2][2][4][2], const Unit& u, int wr, int wc, int fr, int fq) const {
        const int row0 = u.pm * BM + wr * 64 + fr, col0 = u.pn * BM + wc * 32 + 8 * fq;
        int j0[2]; bool rope[2];
#pragma unroll
        for (int bj = 0; bj < 2; ++bj) { const int c0 = col0 + bj * HALF, h = c0 / 192, w = c0 - h * 192; rope[bj] = (w >= 128); j0[bj] = rope[bj] ? ((w - 128) >> 1) : 0; }
#pragma unroll
        for (int ai = 0; ai < 2; ++ai)
#pragma unroll
            for (int m = 0; m < 4; ++m) { const int row = row0 + ai * HALF + m * 16; const float s = rq[row] * qs; bf16_t* rowp = Q + (size_t)row * 1536 + col0;
#pragma unroll
                for (int bj = 0; bj < 2; ++bj) { f32x4 v0 = acc[ai][bj][m][0] * s, v1 = acc[ai][bj][m][1] * s;
                    if (rope[bj]) { const f32x4 c = *(const f32x4*)(cs + (size_t)row * 32 + j0[bj]), sv = *(const f32x4*)(sn + (size_t)row * 32 + j0[bj]);
                        const f32x4 a0 = v0, a1 = v1;
                        v0[0] = a0[0] * c[0] - a0[1] * sv[0]; v0[1] = a0[0] * sv[0] + a0[1] * c[0];
                        v0[2] = a0[2] * c[1] - a0[3] * sv[1]; v0[3] = a0[2] * sv[1] + a0[3] * c[1];
                        v1[0] = a1[0] * c[2] - a1[1] * sv[2]; v1[1] = a1[0] * sv[2] + a1[1] * c[2];
                        v1[2] = a1[2] * c[3] - a1[3] * sv[3]; v1[3] = a1[2] * sv[3] + a1[3] * c[3]; }
                    u32x4 w; w.x = cvt_pk_bf16(v0[0], v0[1]); w.y = cvt_pk_bf16(v0[2], v0[3]); w.z = cvt_pk_bf16(v1[0], v1[1]); w.w = cvt_pk_bf16(v1[2], v1[3]);
                    *(u32x4*)(rowp + bj * HALF) = w; } }
    }
};
struct EpiBf16ColScale {
    static constexpr bool PERM = true;
    bf16_t* O; int ldc; const float* csc;
    __device__ __forceinline__ void operator()(const f32x4 (&acc)[2][2][4][2], const Unit& u, int wr, int wc, int fr, int fq) const {
        const int row0 = u.pm * BM + wr * 64 + fr, col0 = u.pn * BM + wc * 32 + 8 * fq;
        f32x4 sc[2][2];
#pragma unroll
        for (int bj = 0; bj < 2; ++bj)
#pragma unroll
            for (int n = 0; n < 2; ++n) sc[bj][n] = *(const f32x4*)(csc + col0 + bj * HALF + 4 * n);
#pragma unroll
        for (int ai = 0; ai < 2; ++ai)
#pragma unroll
            for (int m = 0; m < 4; ++m) { const int row = row0 + ai * HALF + m * 16; bf16_t* rowp = O + (size_t)row * ldc + col0;
#pragma unroll
                for (int bj = 0; bj < 2; ++bj) { const f32x4 v0 = acc[ai][bj][m][0] * sc[bj][0], v1 = acc[ai][bj][m][1] * sc[bj][1];
                    u32x4 w; w.x = cvt_pk_bf16(v0[0], v0[1]); w.y = cvt_pk_bf16(v0[2], v0[3]); w.z = cvt_pk_bf16(v1[0], v1[1]); w.w = cvt_pk_bf16(v1[2], v1[3]);
                    *(u32x4*)(rowp + bj * HALF) = w; } }
    }
};
struct EpiResF32 {
    static constexpr bool PERM = false;
    const float* res; float* Y; int ldc; float alpha;
    __device__ __forceinline__ void operator()(const f32x4 (&acc)[2][2][4][2], const Unit& u, int wr, int wc, int fr, int fq) const {
        const int row0 = u.pm * BM + wr * 64 + fr, col0 = u.pn * BM + wc * 32 + 4 * fq;
#pragma unroll
        for (int ai = 0; ai < 2; ++ai)
#pragma unroll
            for (int m = 0; m < 4; ++m) { const size_t off = (size_t)(row0 + ai * HALF + m * 16) * ldc + col0;
#pragma unroll
                for (int bj = 0; bj < 2; ++bj)
#pragma unroll
                    for (int n = 0; n < 2; ++n) { const size_t p = off + bj * HALF + n * 16; const f32x4 r = *(const f32x4*)(res + p); *(f32x4*)(Y + p) = r * alpha + acc[ai][bj][m][n]; } }
    }
};
struct EpiSwiGLU {
    static constexpr bool PERM = true;
    bf16_t* H; int ldc;
    __device__ __forceinline__ float sg(float g, float u) const { return g * u * __builtin_amdgcn_rcpf(1.0f + __builtin_amdgcn_exp2f(-1.4426950408889634f * g)); }
    __device__ __forceinline__ void operator()(const f32x4 (&acc)[2][2][4][2], const Unit& u, int wr, int wc, int fr, int fq) const {
        const int row0 = u.pm * BM + wr * 64 + fr, col0 = u.pn * HALF + wc * 32 + 8 * fq;
#pragma unroll
        for (int ai = 0; ai < 2; ++ai)
#pragma unroll
            for (int m = 0; m < 4; ++m) { bf16_t* rowp = H + (size_t)(row0 + ai * HALF + m * 16) * ldc + col0;
                const f32x4 g0 = acc[ai][0][m][0], g1 = acc[ai][0][m][1], u0 = acc[ai][1][m][0], u1 = acc[ai][1][m][1];
                u32x4 w; w.x = cvt_pk_bf16(sg(g0[0], u0[0]), sg(g0[1], u0[1])); w.y = cvt_pk_bf16(sg(g0[2], u0[2]), sg(g0[3], u0[3]));
                w.z = cvt_pk_bf16(sg(g1[0], u1[0]), sg(g1[1], u1[1])); w.w = cvt_pk_bf16(sg(g1[2], u1[2]), sg(g1[3], u1[3]));
                *(u32x4*)rowp = w; }
    }
};

template <class Epi, class Sched, bool ALIGN_EPI = true>
__device__ __forceinline__ void gemm_phase(PG8_LAS unsigned char* lds, const Gemm g, const Sched& S, const Epi& E) {
    int tid_ = threadIdx.x; asm volatile("" : "+v"(tid_));
    const int tid = tid_, wid = __builtin_amdgcn_readfirstlane(tid >> 6), lane = tid & 63, wr = wid >> 2, wc = wid & 3, fr = lane & 15, fq = lane >> 4;
    const int K = g.K, nt = K / BK;
    unsigned voffA[2], voffB[2];
#pragma unroll
    for (int i = 0; i < 2; ++i) { int R, C; stage_rc(tid * 16 + i * 8192, R, C); const int Rb = Epi::PERM ? ((R & ~31) + perm32(R & 31)) : R;
        voffA[i] = (unsigned)(R * g.lda + C) * 2u; voffB[i] = (unsigned)(Rb * (g.ldb ? g.ldb : BK) + C) * 2u; }
    const size_t kstep = (size_t)(BK * 2), kstepB = g.ldb ? kstep : (size_t)BM * BK * 2;
    const size_t hstepA = (size_t)HALF * g.lda * 2, hstepB = g.ldb ? (size_t)HALF * g.ldb * 2 : (size_t)HALF * BK * 2;
    const size_t tstepA = 2 * hstepA, tstepB = g.ldb ? 2 * hstepB : (size_t)(K / BK) * BM * BK * 2;
    const unsigned ldsw = (unsigned)wid * 1024u;
    const int aoff = lds_byte(wr * 64 + fr, fq * 8), boff = lds_byte(wc * 32 + fr, fq * 8);
#define PG8_SA(b, h) (((b) * 2 + (h)) * HTB)
#define PG8_SB(b, h) ((4 + (b) * 2 + (h)) * HTB)
#define PG8_STAGE(bufoff, gbase, voff) do { _Pragma("unroll") for (int _i = 0; _i < 2; ++_i) \
        __builtin_amdgcn_global_load_lds((const unsigned*)((const char*)(gbase) + (voff)[_i]), (PG8_LAS unsigned*)(lds + (bufoff) + ldsw + _i * 8192), 16, 0, 0); } while (0)
#define PG8_LDA(dst, b, h) do { _Pragma("unroll") for (int m = 0; m < 4; ++m) _Pragma("unroll") for (int k = 0; k < 2; ++k) dst[m][k] = *(const PG8_LAS bf16x8*)(lds + PG8_SA(b, h) + aoff + m * 2048 + k * 1024); } while (0)
#define PG8_LDB(dst, b, h) do { _Pragma("unroll") for (int n = 0; n < 2; ++n) _Pragma("unroll") for (int k = 0; k < 2; ++k) dst[n][k] = *(const PG8_LAS bf16x8*)(lds + PG8_SB(b, h) + boff + n * 2048 + k * 1024); } while (0)
#define PG8_MMA(ai, bj, At, Bt) do { __builtin_amdgcn_s_setprio(1); _Pragma("unroll") for (int m = 0; m < 4; ++m) _Pragma("unroll") for (int n = 0; n < 2; ++n) _Pragma("unroll") for (int k = 0; k < 2; ++k) \
        acc[ai][bj][m][n] = __builtin_amdgcn_mfma_f32_16x16x32_bf16(Bt[n][k], At[m][k], acc[ai][bj][m][n], 0, 0, 0); __builtin_amdgcn_s_setprio(0); } while (0)
#define PG8_WAIT_V(n) asm volatile("s_waitcnt vmcnt(" #n ")" ::: "memory")
#define PG8_WAIT_L(n) asm volatile("s_waitcnt lgkmcnt(" #n ")" ::: "memory")
#define PG8_BAR __builtin_amdgcn_s_barrier()
#define PG8_SCHED __builtin_amdgcn_sched_barrier(0)
    Unit cur, nxt; int ui = 0;
    if (!S.next(0, cur)) return;
    f32x4 acc[2][2][4][2];
#pragma unroll
    for (int a = 0; a < 2; ++a)
#pragma unroll
        for (int b = 0; b < 2; ++b)
#pragma unroll
            for (int m = 0; m < 4; ++m)
#pragma unroll
                for (int n = 0; n < 2; ++n) acc[a][b][m][n] = (f32x4){0.f, 0.f, 0.f, 0.f};
    bf16x8 At[4][2], B0[2][2], B1[2][2];
    const char* cA = (const char*)g.A + (size_t)cur.pm * tstepA + (size_t)cur.pn * g.acs; const char* cB = (const char*)g.Bt + (size_t)cur.pn * tstepB;
    S.a_ready(cur);
    PG8_STAGE(PG8_SB(0, 0), cB, voffB); PG8_STAGE(PG8_SB(0, 1), cB + hstepB, voffB); PG8_STAGE(PG8_SA(0, 0), cA, voffA); PG8_STAGE(PG8_SA(0, 1), cA + hstepA, voffA);
    if (wr == 1) PG8_BAR;
    PG8_WAIT_V(2); PG8_BAR;
    PG8_STAGE(PG8_SB(1, 0), cB + kstepB, voffB); PG8_STAGE(PG8_SA(1, 0), cA + kstep, voffA); PG8_STAGE(PG8_SB(1, 1), cB + hstepB + kstepB, voffB);
    PG8_WAIT_V(6); PG8_BAR;
    for (;;) {
        const bool has_next = S.next(ui + 1, nxt);
        const char* nA = has_next ? (const char*)g.A + (size_t)nxt.pm * tstepA + (size_t)nxt.pn * g.acs : cA; const char* nB = has_next ? (const char*)g.Bt + (size_t)nxt.pn * tstepB : cB;
        for (int t = 0; t < nt; t += 2) {
            asm volatile("" : "+v"(voffA[0]), "+v"(voffA[1]), "+v"(voffB[0]), "+v"(voffB[1]));
            const bool last = (t == nt - 2);
            const char* a1 = cA + (size_t)(t + 1) * kstep;
            const char* a2 = last ? nA : cA + (size_t)(t + 2) * kstep; const char* b2 = last ? nB : cB + (size_t)(t + 2) * kstepB;
            const char* a3 = a2 + kstep; const char* b3 = b2 + kstepB;
            if (last && has_next) S.a_ready(nxt);
            PG8_LDB(B0, 0, 0); PG8_LDB(B1, 0, 1); PG8_SCHED; PG8_LDA(At, 0, 0); PG8_STAGE(PG8_SA(1, 1), a1 + hstepA, voffA);
            PG8_WAIT_V(8); PG8_WAIT_L(0); PG8_BAR; PG8_MMA(0, 0, At, B0); PG8_MMA(0, 1, At, B1); PG8_BAR; PG8_SCHED;
            PG8_LDA(At, 0, 1); PG8_STAGE(PG8_SB(0, 0), b2, voffB); PG8_STAGE(PG8_SB(0, 1), b2 + hstepB, voffB); PG8_STAGE(PG8_SA(0, 0), a2, voffA);
            PG8_WAIT_V(8); PG8_WAIT_L(0); PG8_BAR; PG8_MMA(1, 0, At, B0); PG8_MMA(1, 1, At, B1); PG8_BAR; PG8_SCHED;
            PG8_LDB(B0, 1, 0); PG8_LDB(B1, 1, 1); PG8_SCHED; PG8_LDA(At, 1, 0); PG8_STAGE(PG8_SA(0, 1), a2 + hstepA, voffA);
            PG8_WAIT_V(8); PG8_WAIT_L(0); PG8_BAR; PG8_MMA(0, 0, At, B0); PG8_MMA(0, 1, At, B1); PG8_BAR; PG8_SCHED;
            PG8_LDA(At, 1, 1); PG8_STAGE(PG8_SB(1, 0), b3, voffB); PG8_STAGE(PG8_SB(1, 1), b3 + hstepB, voffB); PG8_STAGE(PG8_SA(1, 0), a3, voffA);
            PG8_WAIT_V(8); PG8_WAIT_L(0); PG8_BAR; PG8_MMA(1, 0, At, B0); PG8_MMA(1, 1, At, B1); PG8_BAR; PG8_SCHED;
        }
        if constexpr (ALIGN_EPI) { if (wr == 0) PG8_BAR; }
        E(acc, cur, wr, wc, fr, fq);
#ifdef MK_EPI_TWICE
        asm volatile("" ::: "memory"); E(acc, cur, wr, wc, fr, fq);
#endif
        S.done(cur);
        if (!has_next) break;
#pragma unroll
        for (int a = 0; a < 2; ++a)
#pragma unroll
            for (int b = 0; b < 2; ++b)
#pragma unroll
                for (int m = 0; m < 4; ++m)
#pragma unroll
                    for (int n = 0; n < 2; ++n) acc[a][b][m][n] = (f32x4){0.f, 0.f, 0.f, 0.f};
        cur = nxt; cA = nA; cB = nB; ++ui;
        if constexpr (ALIGN_EPI) { if (wr == 1) PG8_BAR; }
    }
    PG8_WAIT_V(0);
    if constexpr (!ALIGN_EPI) { if (wr == 0) PG8_BAR; }
    PG8_BAR;
#undef PG8_SA
#undef PG8_SB
#undef PG8_STAGE
#undef PG8_LDA
#undef PG8_LDB
#undef PG8_MMA
#undef PG8_WAIT_V
#undef PG8_WAIT_L
#undef PG8_BAR
#undef PG8_SCHED
}
}
constexpr bool XL_LN1 = false, XL_LN2 = false;
constexpr int NWAVES = 8;
#ifndef MK_ONE_LAUNCH
#define MK_ONE_LAUNCH 1
#endif
#ifndef MLA_UNIT
#define MLA_UNIT unit
#endif
#ifndef MK_MLA_CONV
#define MK_MLA_CONV 1
#endif
#ifndef MK_NAIVE_MLA
#define MK_NAIVE_MLA 0
#endif
#ifndef MK_NAIVE_DIL
#define MK_NAIVE_DIL 0
#endif

constexpr int SEQ = 16384, DM = 4096, DEPTH = 4, M = SEQ;
constexpr int INW = 8512, INWP = 8704, FFN = 11008;
constexpr int C_U = 0, C_Q = 1024, C_K = 2048, C_V = 3072, C_H = 4096, C_B = 5120, C_C = 6144, C_CQ = 7168, C_CKV = 7936, C_KR = 8448;
constexpr int QRANK = 768, KVRANK = 512, NHEAD = 8;
constexpr float LN_EPS = 1e-5f, RMS_EPS = 1e-6f;
constexpr float ALPHA = 1.681792830507429f;
constexpr float QSCALE = 0.07216878364870322f * 1.4426950408889634f;
constexpr float DIL_SCALE = 0.08838834764831845f;
constexpr int NPH = 9, NPHASES = 1 + DEPTH * NPH;

constexpr size_t MiB = 1u << 20;
constexpr size_t WS_CTL = 0, CTL_ZERO_BYTES = 1 * MiB;
constexpr size_t WS_BIAS = 1 * MiB, WS_RQ = 1 * MiB + 65536, WS_RKV = 1 * MiB + 2 * 65536;
constexpr size_t WS_COS = 2 * MiB, WS_SIN = 4 * MiB, WS_KR = 6 * MiB;
constexpr size_t WS_W = 8 * MiB, W_LAYER = 363 * MiB;
constexpr size_t W_IN = 0, W_OUT = 68 * MiB, W_GU = 100 * MiB, W_DN = 272 * MiB, W_UQ = 358 * MiB, W_UK = 360 * MiB + 512 * 1024, W_UV = 361 * MiB + 512 * 1024, W_POOL = 362 * MiB + 512 * 1024;
constexpr size_t WS_XB = WS_W + DEPTH * W_LAYER;
constexpr size_t WS_PROJ = WS_XB + 128 * MiB;
constexpr size_t WS_MIX = WS_PROJ + 272 * MiB;
constexpr size_t WS_HID = WS_PROJ;
constexpr size_t WS_PD = WS_MIX + 128 * MiB;
constexpr size_t WS_Q = WS_PD + 32 * MiB;
constexpr size_t WS_KN = WS_Q + 48 * MiB;
constexpr size_t WS_VT = WS_KN + 32 * MiB;
constexpr size_t WS_DSO = WS_VT + 32 * MiB;
constexpr size_t WS_DSML = WS_DSO + 64 * MiB;
constexpr size_t WS_XL = WS_DSML + 1 * MiB;
constexpr size_t WS_END = WS_XL + 128 * MiB;
constexpr size_t WS_YB = WS_PD;
static_assert(WS_YB + 128 * MiB <= WS_DSO, "YB overlay");
static_assert((size_t)M * FFN * 2 <= 400 * MiB && (size_t)INWP * DM * 2 == 68 * MiB && (size_t)2 * FFN * DM * 2 == 172 * MiB && (size_t)DM * FFN * 2 == 86 * MiB, "d_ws map");
constexpr int CW_TMO = 0, CW_CODE = 1;
constexpr int CW_BAR = 4096;

constexpr int RING_OFF = 0, RING_BYTES = 131072;
constexpr int LDSCTL_OFF = RING_BYTES, MISC_OFF = LDSCTL_OFF + 320;
constexpr int BGSLOT_HI = LDSCTL_OFF + 1024;
constexpr int LDS_BYTES = 153600;
static_assert(MISC_OFF + 128 <= BGSLOT_HI && BGSLOT_HI + 5 * 4224 <= LDS_BYTES, "LDS map");

#define GAS __attribute__((address_space(1)))
#define LAS __attribute__((address_space(3)))
typedef unsigned short bf16;
typedef unsigned v4u __attribute__((ext_vector_type(4)));
typedef float f32x4 __attribute__((ext_vector_type(4)));
typedef GAS unsigned gu32;
#define RLX_AGENT __ATOMIC_RELAXED, __HIP_MEMORY_SCOPE_AGENT
#define LDS_WAIT() asm volatile("s_waitcnt lgkmcnt(0)" ::: "memory")
#define VM_WAIT() asm volatile("s_waitcnt vmcnt(0)" ::: "memory")
__device__ __forceinline__ unsigned f2bf(float f) { unsigned u = __builtin_bit_cast(unsigned, f); return (u + 0x7fffu + ((u >> 16) & 1u)) >> 16; }
__device__ __forceinline__ unsigned pk2(float lo, float hi) { return f2bf(lo) | (f2bf(hi) << 16); }
__device__ __forceinline__ float bflo(unsigned w) { return __builtin_bit_cast(float, w << 16); }
__device__ __forceinline__ float bfhi(unsigned w) { return __builtin_bit_cast(float, w & 0xffff0000u); }
__device__ __forceinline__ float bf2f(bf16 b) { return __builtin_bit_cast(float, (unsigned)b << 16); }

#define XB_TMO      128
#define XB_XCNT(j)  (256  + 64 * (j))
#define XB_XSUB(j)  (1280 + 64 * (j))
#define XB_XGEN(j)  (2304 + 64 * (j))
#define XB_TOP      3328
#define XB_TOPGEN   3392
#define XCD_BAR_WORDS 3456
#define XB_SPIN_CAP (1u << 22)

__device__ __forceinline__ unsigned xb_ld(unsigned* p)              { return __hip_atomic_load(p, __ATOMIC_RELAXED, __HIP_MEMORY_SCOPE_AGENT); }
__device__ __forceinline__ unsigned xb_add(unsigned* p, unsigned v) { return __hip_atomic_fetch_add(p, v, __ATOMIC_RELAXED, __HIP_MEMORY_SCOPE_AGENT); }
__device__ __forceinline__ unsigned xb_xcc_id() { return (unsigned)__builtin_amdgcn_s_getreg((3 << 11) | 20) & 0xFu; }
#define XB_SPIN(cond, bar) do { unsigned _sp = 0; while (cond) { __builtin_amdgcn_s_sleep(1); \
    if ((++_sp & 255u) == 0u) { if (xb_ld(&(bar)[XB_TMO])) break; if (_sp > XB_SPIN_CAP) { atomicAdd(&(bar)[XB_TMO], 1u); break; } } } } while (0)

struct XcdBarrier {
    unsigned* bar; unsigned x;
    volatile LAS unsigned* st;
};
__device__ __forceinline__ XcdBarrier xcd_barrier_post(unsigned* bar, volatile LAS unsigned* st) {
    XcdBarrier b; b.bar = bar; b.x = xb_xcc_id(); b.st = st;
    if (threadIdx.x == 0) (void)xb_add(&bar[XB_XCNT(b.x)], 1u);
    return b;
}
__device__ __forceinline__ void xcd_barrier_complete(unsigned* bar, unsigned x, unsigned& nloc, unsigned& nx) {
    const unsigned G = gridDim.x * gridDim.y * gridDim.z;
    unsigned sum, cnt, mine, sp = 0u;
    for (;;) {
        sum = 0u; cnt = 0u; mine = 0u;
#pragma unroll
        for (unsigned j = 0; j < 16; ++j) { const unsigned c = xb_ld(&bar[XB_XCNT(j)]); sum += c; cnt += (c > 0u) ? 1u : 0u; mine = (j == x) ? c : mine; }
        if (sum == G) break;
        __builtin_amdgcn_s_sleep(1);
        if ((++sp & 255u) == 0u) { if (xb_ld(&bar[XB_TMO])) break; if (sp > XB_SPIN_CAP) { atomicAdd(&bar[XB_TMO], 1u); break; } }
    }
    nloc = mine > 0u ? mine : 1u; nx = cnt > 0u ? cnt : 1u;
}
__device__ __forceinline__ void xcd_barrier(const XcdBarrier& b) {
    asm volatile("s_waitcnt vmcnt(0)" ::: "memory");
    __syncthreads();
    if (threadIdx.x == 0) {
        unsigned* bar = b.bar;
        __builtin_amdgcn_s_waitcnt(0);
        unsigned nloc = b.st[0], nx = b.st[1];
        if (nloc == 0u) { xcd_barrier_complete(bar, b.x, nloc, nx); b.st[0] = nloc; b.st[1] = nx; }
        const unsigned old = xb_add(&bar[XB_XSUB(b.x)], 1u);
        const unsigned gen = old / nloc;
        if (old + 1u == (gen + 1u) * nloc) {
            __builtin_amdgcn_fence(__ATOMIC_RELEASE, "agent");
            asm volatile("s_waitcnt vmcnt(0)" ::: "memory");
            const unsigned og = xb_add(&bar[XB_TOP], 1u);
            const unsigned tg = og / nx;
            if (og + 1u == (tg + 1u) * nx) xb_add(&bar[XB_TOPGEN], 1u);
            else XB_SPIN(xb_ld(&bar[XB_TOPGEN]) == tg, bar);
            __builtin_amdgcn_fence(__ATOMIC_ACQUIRE, "agent");
            xb_add(&bar[XB_XGEN(b.x)], 1u);
            asm volatile("s_waitcnt vmcnt(0)" ::: "memory");
        } else {
            XB_SPIN(xb_ld(&bar[XB_XGEN(b.x)]) == gen, bar);
            __builtin_amdgcn_fence(__ATOMIC_ACQUIRE, "agent");
            asm volatile("s_waitcnt vmcnt(0)" ::: "memory");
        }
    }
    __syncthreads();
}

__device__ __forceinline__ float wave_sum(float v) {
#pragma unroll
    for (int o = 1; o < 64; o <<= 1) v += __shfl_xor(v, o);
    return v;
}
__device__ __forceinline__ float wave_max(float v) {
#pragma unroll
    for (int o = 1; o < 64; o <<= 1) v = fmaxf(v, __shfl_xor(v, o));
    return v;
}
__device__ const unsigned char T5_BUCKET[3 * 129] = {
0,1,2,3,4,5,6,7,8,9,10,11,12,13,14,15,16,16,16,16,16,16,17,17,17,17,17,17,17,17,18,18,18,18,18,18,18,18,18,18,19,19,19,19,19,19,19,19,19,19,19,19,19,19,20,20,20,20,20,20,20,20,20,20,20,20,20,20,20,20,20,20,20,21,21,21,21,21,21,21,21,21,21,21,21,21,21,21,21,21,21,21,21,21,21,21,21,21,21,22,22,22,22,22,22,22,22,22,22,22,22,22,22,22,22,22,22,22,22,22,22,22,22,22,22,22,22,22,22,
0,4,8,12,16,16,17,17,18,18,19,19,19,19,20,20,20,20,20,21,21,21,21,21,21,22,22,22,22,22,22,22,22,22,23,23,23,23,23,23,23,23,23,23,23,23,24,24,24,24,24,24,24,24,24,24,24,24,24,24,24,24,25,25,25,25,25,25,25,25,25,25,25,25,25,25,25,25,25,25,25,25,25,26,26,26,26,26,26,26,26,26,26,26,26,26,26,26,26,26,26,26,26,26,26,26,26,26,26,26,26,26,26,27,27,27,27,27,27,27,27,27,27,27,27,27,27,27,27,
0,16,18,19,20,21,21,22,22,23,23,23,24,24,24,24,25,25,25,25,25,26,26,26,26,26,26,26,26,27,27,27,27,27,27,27,27,27,27,28,28,28,28,28,28,28,28,28,28,28,28,28,29,29,29,29,29,29,29,29,29,29,29,29,29,29,29,29,29,29,30,30,30,30,30,30,30,30,30,30,30,30,30,30,30,30,30,30,30,30,30,30,30,30,30,31,31,31,31,31,31,31,31,31,31,31,31,31,31,31,31,31,31,31,31,31,31,31,31,31,31,31,31,31,31,31,31,31,31};

__device__ __forceinline__ size_t wt_off(int r, int k, int ldt, int nkt) { return nkt ? ((size_t)((r >> 8) * nkt + (k >> 6)) * 256 + (r & 255)) * 64 + (k & 63) : (size_t)r * ldt + k; }
__device__ __forceinline__ void tr_item(const float* W, int N, int k0, int ns0, bf16* WT, int ldt, int orow0, int ostride, const float* gk, const float* gn, LAS float* scr, int lane, int nkt) {
    const float gnv = gn ? gn[ns0 + (lane & 31)] : 1.f;
#pragma unroll 8
    for (int i = 0; i < 32; ++i) { const int kk = 2 * i + (lane >> 5); float v = W[(size_t)(k0 + kk) * N + ns0 + (lane & 31)] * gnv; if (gk) v *= gk[k0 + kk]; scr[kk * 33 + (lane & 31)] = v; }
    LDS_WAIT(); asm volatile("" ::: "memory");
    const int c = lane & 7;
#pragma unroll
    for (int j = 0; j < 4; ++j) { const int n = (lane >> 3) + 8 * j; const LAS float* s = scr + (8 * c) * 33 + n;
        v4u o; o.x = pk2(s[0 * 33], s[1 * 33]); o.y = pk2(s[2 * 33], s[3 * 33]); o.z = pk2(s[4 * 33], s[5 * 33]); o.w = pk2(s[6 * 33], s[7 * 33]);
        *(v4u*)(WT + wt_off(orow0 + ostride * n, k0 + 8 * c, ldt, nkt)) = o; }
    LDS_WAIT(); asm volatile("" ::: "memory");
}
__device__ __forceinline__ void sincos_acc(float angf, float& sn, float& cs) {
    const double x = (double)angf;
    const double q = __builtin_rint(x * 0.63661977236758134308);
    double y = __builtin_fma(-q, 1.57079632679489655800, x); y = __builtin_fma(-q, 6.12323399573676603587e-17, y);
    const double y2 = y * y;
    double s = -7.647163731819816e-13;
    s = s * y2 + 1.6059043836821613e-10; s = s * y2 - 2.505210838544172e-08; s = s * y2 + 2.7557319223985893e-06; s = s * y2 - 1.984126984126984e-04; s = s * y2 + 8.333333333333333e-03; s = s * y2 - 1.6666666666666666e-01; s = y + y * y2 * s;
    double c = -1.1470745597729725e-11;
    c = c * y2 + 2.08767569878681e-09; c = c * y2 - 2.755731922398589e-07; c = c * y2 + 2.48015873015873e-05; c = c * y2 - 1.388888888888889e-03; c = c * y2 + 4.1666666666666664e-02; c = c * y2 - 0.5; c = c * y2 + 1.0;
    const long long qi = (long long)q; const int k = (int)(qi & 3);
    const double ss = (k == 0) ? s : (k == 1) ? c : (k == 2) ? -s : -c;
    const double cc = (k == 0) ? c : (k == 1) ? -s : (k == 2) ? -c : s;
    sn = (float)ss; cs = (float)cc;
}
namespace mla {
typedef float f32x16 __attribute__((ext_vector_type(16)));
typedef short bf16x8 __attribute__((ext_vector_type(8)));
typedef unsigned u32x4 __attribute__((ext_vector_type(4)));
typedef unsigned u32x2 __attribute__((ext_vector_type(2)));
constexpr int KN_ROW = 272, KR_ROW = 144, VT_ROW = 144;
constexpr int KN_BYTES = 64 * KN_ROW, KR_BYTES = 64 * KR_ROW, VT_BYTES = 128 * VT_ROW;
constexpr int KN_OFF = 0, KR_OFF = KN_BYTES, VT_OFF = KN_BYTES + KR_BYTES, BUF_BYTES = KN_BYTES + KR_BYTES + VT_BYTES;
constexpr int NP_KN = KN_BYTES / 1024, NP_KR = KR_BYTES / 1024, NP_VT = VT_BYTES / 1024, NPIECE = NP_KN + NP_KR + NP_VT;
static_assert(NP_KN * 1024 == KN_BYTES && NP_KR * 1024 == KR_BYTES && NP_VT * 1024 == VT_BYTES && 2 * BUF_BYTES + 8 * 4096 <= 131072, "mla LDS map");
__device__ __forceinline__ int swap23(int x) { return (x & ~12) | ((x & 4) << 1) | ((x & 8) >> 1); }
__device__ __forceinline__ unsigned cvtpk(float lo, float hi) { unsigned r; asm volatile("v_cvt_pk_bf16_f32 %0, %1, %2" : "=v"(r) : "v"(lo), "v"(hi)); return r; }
__device__ __forceinline__ float xmax32(float v) { auto rr = __builtin_amdgcn_permlane32_swap(__float_as_uint(v), __float_as_uint(v), false, false); const unsigned r0 = rr[0], r1 = rr[1];
    return fmaxf(__uint_as_float(r0), __uint_as_float(r1)); }
__device__ __forceinline__ float xsum32(float v) { auto rr = __builtin_amdgcn_permlane32_swap(__float_as_uint(v), __float_as_uint(v), false, false); const unsigned r0 = rr[0], r1 = rr[1];
    return __uint_as_float(r0) + __uint_as_float(r1); }

__device__ __forceinline__ unsigned piece_voff(int P, int lane) {
    if (P < NP_KN) { const int s = 64 * P + lane, rho = s / 17; int ch = s - rho * 17; if (ch == 16) ch = 0; const int keyl = (rho & 32) | swap23(rho & 31); return (unsigned)(keyl * 2048 + ch * 16); }
    if (P < NP_KN + NP_KR) { const int s = 64 * (P - NP_KN) + lane, rho = s / 9; int ch = s - rho * 9; if (ch == 8) ch = 0; const int keyl = (rho & 32) | swap23(rho & 31); return (unsigned)(keyl * 128 + ch * 16); }
    { const int s = 64 * (P - NP_KN - NP_KR) + lane, row = s / 9; int ch = s - row * 9; if (ch == 8) ch = 0; return (unsigned)(row * (M * 2) + ch * 16); }
}

struct NoBg { int nfly; __device__ __forceinline__ void pre(int) {} __device__ __forceinline__ void post(int) {} };
template <class BG>
__device__ __forceinline__ void unit(LAS unsigned char* lds, const bf16* Q, const bf16* KN, const bf16* KR, const bf16* VT, bf16* MIX, int h, int qb, BG& bg) {
    int tid_ = threadIdx.x; asm volatile("" : "+v"(tid_));
    const int lane = tid_ & 63, wave = __builtin_amdgcn_readfirstlane(tid_ >> 6), c = lane & 31, hi = lane >> 5;
    const int q0 = qb * 256 + wave * 32, ntile = 4 * (qb + 1);
    unsigned voff[6];
#pragma unroll
    for (int k = 0; k < 6; ++k) voff[k] = piece_voff((wave + 8 * k) < NPIECE ? (wave + 8 * k) : 0, lane);
    const char* knb = (const char*)KN + (size_t)h * 256; const char* krb = (const char*)KR; const char* vtb = (const char*)VT + (size_t)h * 128 * (M * 2);
#define MLA_ISSUE(j, bufb) do { const size_t key0_ = (size_t)(j) * 64; \
        _Pragma("unroll") for (int k = 0; k < 6; ++k) { const int P = wave + 8 * k; if (P < NPIECE) { \
            const char* gb = (P < NP_KN) ? knb + key0_ * 2048 : (P < NP_KN + NP_KR) ? krb + key0_ * 128 : vtb + key0_ * 2; \
            __builtin_amdgcn_global_load_lds((const unsigned*)(gb + voff[k]), (LAS unsigned*)(lds + (bufb) + P * 1024), 16, 0, 0); } } } while (0)
    bf16x8 qf[12];
    { const bf16* qrow = Q + (size_t)(q0 + c) * 1536 + h * 192 + 8 * hi;
#pragma unroll
      for (int ch = 0; ch < 12; ++ch) qf[ch] = *(const bf16x8*)(qrow + 16 * ch); }
    MLA_ISSUE(0, 0);
    f32x16 O[4];
#pragma unroll
    for (int d = 0; d < 4; ++d)
#pragma unroll
        for (int r = 0; r < 16; ++r) O[d][r] = 0.f;
    float m = -1e30f, l = 0.f;
    const int kn_l = c * KN_ROW + hi * 16, kr_l = c * KR_ROW + hi * 16, vt_l = c * VT_ROW + hi * 16;
    asm volatile("s_waitcnt vmcnt(0)" ::: "memory"); __syncthreads();
    for (int j = 0; j < ntile; ++j) {
        const int bufb = (j & 1) * BUF_BYTES;
        bg.pre(j);
#ifndef MLA_SERIAL
        if (j + 1 < ntile) MLA_ISSUE(j + 1, BUF_BYTES - bufb);
#endif
        bg.post(j);
        const int key0 = j * 64;
        if (key0 <= q0 + 31) {
            const LAS unsigned char* kb = lds + bufb;
            f32x16 S0, S1;
#pragma unroll
            for (int r = 0; r < 16; ++r) { S0[r] = 0.f; S1[r] = 0.f; }
#pragma unroll
            for (int ch = 0; ch < 8; ++ch) {
                const bf16x8 a0 = *(const LAS bf16x8*)(kb + KN_OFF + kn_l + ch * 32), a1 = *(const LAS bf16x8*)(kb + KN_OFF + 32 * KN_ROW + kn_l + ch * 32);
                S0 = __builtin_amdgcn_mfma_f32_32x32x16_bf16(a0, qf[ch], S0, 0, 0, 0); S1 = __builtin_amdgcn_mfma_f32_32x32x16_bf16(a1, qf[ch], S1, 0, 0, 0); }
#pragma unroll
            for (int ch = 0; ch < 4; ++ch) {
                const bf16x8 a0 = *(const LAS bf16x8*)(kb + KR_OFF + kr_l + ch * 32), a1 = *(const LAS bf16x8*)(kb + KR_OFF + 32 * KR_ROW + kr_l + ch * 32);
                S0 = __builtin_amdgcn_mfma_f32_32x32x16_bf16(a0, qf[8 + ch], S0, 0, 0, 0); S1 = __builtin_amdgcn_mfma_f32_32x32x16_bf16(a1, qf[8 + ch], S1, 0, 0, 0); }
            if (key0 + 63 > q0) {
                const int lim = q0 + c - key0 - 8 * hi;
#pragma unroll
                for (int r = 0; r < 16; ++r) { const int ko = 16 * (r >> 3) + (r & 7); if (ko > lim) S0[r] = -__builtin_inff(); if (ko + 32 > lim) S1[r] = -__builtin_inff(); }
            }
            float pm = S0[0];
#pragma unroll
            for (int r = 1; r < 16; ++r) pm = fmaxf(pm, S0[r]);
#pragma unroll
            for (int r = 0; r < 16; ++r) pm = fmaxf(pm, S1[r]);
            pm = xmax32(pm);
#ifdef MLA_NODEFER
            {
#else
            if (!__all(pm <= m + 8.0f)) {
#endif
                const float mn = fmaxf(m, pm), alpha = __builtin_amdgcn_exp2f(m - mn); m = mn; l *= alpha;
#pragma unroll
                for (int d = 0; d < 4; ++d)
#pragma unroll
                    for (int r = 0; r < 16; ++r) O[d][r] *= alpha;
            }
            float ps = 0.f;
#pragma unroll
            for (int r = 0; r < 16; ++r) { S0[r] = __builtin_amdgcn_exp2f(S0[r] - m); S1[r] = __builtin_amdgcn_exp2f(S1[r] - m); ps += S0[r] + S1[r]; }
            l += ps;
            bf16x8 pf[4];
#pragma unroll
            for (int s = 0; s < 2; ++s) {
                u32x4 w0 = {cvtpk(S0[8 * s + 0], S0[8 * s + 1]), cvtpk(S0[8 * s + 2], S0[8 * s + 3]), cvtpk(S0[8 * s + 4], S0[8 * s + 5]), cvtpk(S0[8 * s + 6], S0[8 * s + 7])};
                u32x4 w1 = {cvtpk(S1[8 * s + 0], S1[8 * s + 1]), cvtpk(S1[8 * s + 2], S1[8 * s + 3]), cvtpk(S1[8 * s + 4], S1[8 * s + 5]), cvtpk(S1[8 * s + 6], S1[8 * s + 7])};
                pf[s] = __builtin_bit_cast(bf16x8, w0); pf[2 + s] = __builtin_bit_cast(bf16x8, w1); }
#pragma unroll
            for (int kc = 0; kc < 4; ++kc)
#pragma unroll
                for (int d = 0; d < 4; ++d) { const bf16x8 a = *(const LAS bf16x8*)(kb + VT_OFF + d * 32 * VT_ROW + vt_l + kc * 32);
                    O[d] = __builtin_amdgcn_mfma_f32_32x32x16_bf16(a, pf[kc], O[d], 0, 0, 0); }
        }
#ifdef MLA_SERIAL
        __syncthreads(); if (j + 1 < ntile) MLA_ISSUE(j + 1, BUF_BYTES - bufb);
#endif
        if (bg.nfly) asm volatile("s_waitcnt vmcnt(4)" ::: "memory"); else asm volatile("s_waitcnt vmcnt(0)" ::: "memory");
        asm volatile("" ::: "memory"); asm volatile("s_waitcnt lgkmcnt(0)" ::: "memory"); __builtin_amdgcn_s_barrier(); asm volatile("" ::: "memory");
    }
    const float il = 1.0f / xsum32(l);
    bf16* orow = MIX + (size_t)(q0 + c) * DM + 3072 + h * 128 + 4 * hi;
#pragma unroll
    for (int d = 0; d < 4; ++d)
#pragma unroll
        for (int g = 0; g < 4; ++g) { u32x2 w = {cvtpk(O[d][4 * g + 0] * il, O[d][4 * g + 1] * il), cvtpk(O[d][4 * g + 2] * il, O[d][4 * g + 3] * il)};
            *(u32x2*)(orow + 32 * d + 8 * g) = w; }
#undef MLA_ISSUE
}
__device__ __forceinline__ void qk_pipe(f32x16& S0, f32x16& S1, unsigned aN, unsigned aR, const bf16x8 (&qf)[12]) {
    bf16x8 f0, f1, f2, f3, f4, f5;
    asm volatile(
        "ds_read_b128 %2, %8 offset:0\n\t"
        "ds_read_b128 %3, %8 offset:8704\n\t"
        "ds_read_b128 %4, %8 offset:32\n\t"
        "ds_read_b128 %5, %8 offset:8736\n\t"
        "ds_read_b128 %6, %8 offset:64\n\t"
        "ds_read_b128 %7, %8 offset:8768\n\t"
        "s_waitcnt lgkmcnt(5)\n\t"
        "v_mfma_f32_32x32x16_bf16 %0, %2, %10, 0\n\t"
        "ds_read_b128 %2, %8 offset:96\n\t"
        "s_waitcnt lgkmcnt(5)\n\t"
        "v_mfma_f32_32x32x16_bf16 %1, %3, %10, 0\n\t"
        "ds_read_b128 %3, %8 offset:8800\n\t"
        "s_waitcnt lgkmcnt(5)\n\t"
        "v_mfma_f32_32x32x16_bf16 %0, %4, %11, %0\n\t"
        "ds_read_b128 %4, %8 offset:128\n\t"
        "s_waitcnt lgkmcnt(5)\n\t"
        "v_mfma_f32_32x32x16_bf16 %1, %5, %11, %1\n\t"
        "ds_read_b128 %5, %8 offset:8832\n\t"
        "s_waitcnt lgkmcnt(5)\n\t"
        "v_mfma_f32_32x32x16_bf16 %0, %6, %12, %0\n\t"
        "ds_read_b128 %6, %8 offset:160\n\t"
        "s_waitcnt lgkmcnt(5)\n\t"
        "v_mfma_f32_32x32x16_bf16 %1, %7, %12, %1\n\t"
        "ds_read_b128 %7, %8 offset:8864\n\t"
        "s_waitcnt lgkmcnt(5)\n\t"
        "v_mfma_f32_32x32x16_bf16 %0, %2, %13, %0\n\t"
        "ds_read_b128 %2, %8 offset:192\n\t"
        "s_waitcnt lgkmcnt(5)\n\t"
        "v_mfma_f32_32x32x16_bf16 %1, %3, %13, %1\n\t"
        "ds_read_b128 %3, %8 offset:8896\n\t"
        "s_waitcnt lgkmcnt(5)\n\t"
        "v_mfma_f32_32x32x16_bf16 %0, %4, %14, %0\n\t"
        "ds_read_b128 %4, %8 offset:224\n\t"
        "s_waitcnt lgkmcnt(5)\n\t"
        "v_mfma_f32_32x32x16_bf16 %1, %5, %14, %1\n\t"
        "ds_read_b128 %5, %8 offset:8928\n\t"
        "s_waitcnt lgkmcnt(5)\n\t"
        "v_mfma_f32_32x32x16_bf16 %0, %6, %15, %0\n\t"
        "ds_read_b128 %6, %9 offset:0\n\t"
        "s_waitcnt lgkmcnt(5)\n\t"
        "v_mfma_f32_32x32x16_bf16 %1, %7, %15, %1\n\t"
        "ds_read_b128 %7, %9 offset:4608\n\t"
        "s_waitcnt lgkmcnt(5)\n\t"
        "v_mfma_f32_32x32x16_bf16 %0, %2, %16, %0\n\t"
        "ds_read_b128 %2, %9 offset:32\n\t"
        "s_waitcnt lgkmcnt(5)\n\t"
        "v_mfma_f32_32x32x16_bf16 %1, %3, %16, %1\n\t"
        "ds_read_b128 %3, %9 offset:4640\n\t"
        "s_waitcnt lgkmcnt(5)\n\t"
        "v_mfma_f32_32x32x16_bf16 %0, %4, %17, %0\n\t"
        "ds_read_b128 %4, %9 offset:64\n\t"
        "s_waitcnt lgkmcnt(5)\n\t"
        "v_mfma_f32_32x32x16_bf16 %1, %5, %17, %1\n\t"
        "ds_read_b128 %5, %9 offset:4672\n\t"
        "s_waitcnt lgkmcnt(5)\n\t"
        "v_mfma_f32_32x32x16_bf16 %0, %6, %18, %0\n\t"
        "ds_read_b128 %6, %9 offset:96\n\t"
        "s_waitcnt lgkmcnt(5)\n\t"
        "v_mfma_f32_32x32x16_bf16 %1, %7, %18, %1\n\t"
        "ds_read_b128 %7, %9 offset:4704\n\t"
        "s_waitcnt lgkmcnt(5)\n\t"
        "v_mfma_f32_32x32x16_bf16 %0, %2, %19, %0\n\t"
        "s_waitcnt lgkmcnt(4)\n\t"
        "v_mfma_f32_32x32x16_bf16 %1, %3, %19, %1\n\t"
        "s_waitcnt lgkmcnt(3)\n\t"
        "v_mfma_f32_32x32x16_bf16 %0, %4, %20, %0\n\t"
        "s_waitcnt lgkmcnt(2)\n\t"
        "v_mfma_f32_32x32x16_bf16 %1, %5, %20, %1\n\t"
        "s_waitcnt lgkmcnt(1)\n\t"
        "v_mfma_f32_32x32x16_bf16 %0, %6, %21, %0\n\t"
        "s_waitcnt lgkmcnt(0)\n\t"
        "v_mfma_f32_32x32x16_bf16 %1, %7, %21, %1\n\t"
        "s_nop 15\n\t"
        "s_nop 3\n\t"
        : "=&v"(S0), "=&v"(S1), "=&v"(f0), "=&v"(f1), "=&v"(f2), "=&v"(f3), "=&v"(f4), "=&v"(f5)
        : "v"(aN), "v"(aR), "v"(qf[0]), "v"(qf[1]), "v"(qf[2]), "v"(qf[3]), "v"(qf[4]), "v"(qf[5]), "v"(qf[6]), "v"(qf[7]), "v"(qf[8]), "v"(qf[9]), "v"(qf[10]), "v"(qf[11])
        : "memory");
}
struct KFrag { bf16x8 f0, f1; };
__device__ __forceinline__ void qk_head(KFrag& t, unsigned aN) {
    asm volatile(
        "ds_read_b128 %0, %2 offset:0\n\t"
        "ds_read_b128 %1, %2 offset:8704\n\t"
        : "=&v"(t.f0), "=&v"(t.f1)
        : "v"(aN)
        : "memory");
}
__device__ __forceinline__ void qk_tail(f32x16& S0, f32x16& S1, KFrag& t, unsigned aN, unsigned aR, const bf16x8 (&qf)[12]) {
    bf16x8 f2, f3, f4, f5;
    asm volatile(
        "ds_read_b128 %4, %8 offset:32\n\t"
        "ds_read_b128 %5, %8 offset:8736\n\t"
        "ds_read_b128 %6, %8 offset:64\n\t"
        "ds_read_b128 %7, %8 offset:8768\n\t"
        "s_waitcnt lgkmcnt(5)\n\t"
        "v_mfma_f32_32x32x16_bf16 %0, %2, %10, 0\n\t"
        "ds_read_b128 %2, %8 offset:96\n\t"
        "s_waitcnt lgkmcnt(5)\n\t"
        "v_mfma_f32_32x32x16_bf16 %1, %3, %10, 0\n\t"
        "ds_read_b128 %3, %8 offset:8800\n\t"
        "s_waitcnt lgkmcnt(5)\n\t"
        "v_mfma_f32_32x32x16_bf16 %0, %4, %11, %0\n\t"
        "ds_read_b128 %4, %8 offset:128\n\t"
        "s_waitcnt lgkmcnt(5)\n\t"
        "v_mfma_f32_32x32x16_bf16 %1, %5, %11, %1\n\t"
        "ds_read_b128 %5, %8 offset:8832\n\t"
        "s_waitcnt lgkmcnt(5)\n\t"
        "v_mfma_f32_32x32x16_bf16 %0, %6, %12, %0\n\t"
        "ds_read_b128 %6, %8 offset:160\n\t"
        "s_waitcnt lgkmcnt(5)\n\t"
        "v_mfma_f32_32x32x16_bf16 %1, %7, %12, %1\n\t"
        "ds_read_b128 %7, %8 offset:8864\n\t"
        "s_waitcnt lgkmcnt(5)\n\t"
        "v_mfma_f32_32x32x16_bf16 %0, %2, %13, %0\n\t"
        "ds_read_b128 %2, %8 offset:192\n\t"
        "s_waitcnt lgkmcnt(5)\n\t"
        "v_mfma_f32_32x32x16_bf16 %1, %3, %13, %1\n\t"
        "ds_read_b128 %3, %8 offset:8896\n\t"
        "s_waitcnt lgkmcnt(5)\n\t"
        "v_mfma_f32_32x32x16_bf16 %0, %4, %14, %0\n\t"
        "ds_read_b128 %4, %8 offset:224\n\t"
        "s_waitcnt lgkmcnt(5)\n\t"
        "v_mfma_f32_32x32x16_bf16 %1, %5, %14, %1\n\t"
        "ds_read_b128 %5, %8 offset:8928\n\t"
        "s_waitcnt lgkmcnt(5)\n\t"
        "v_mfma_f32_32x32x16_bf16 %0, %6, %15, %0\n\t"
        "ds_read_b128 %6, %9 offset:0\n\t"
        "s_waitcnt lgkmcnt(5)\n\t"
        "v_mfma_f32_32x32x16_bf16 %1, %7, %15, %1\n\t"
        "ds_read_b128 %7, %9 offset:4608\n\t"
        "s_waitcnt lgkmcnt(5)\n\t"
        "v_mfma_f32_32x32x16_bf16 %0, %2, %16, %0\n\t"
        "ds_read_b128 %2, %9 offset:32\n\t"
        "s_waitcnt lgkmcnt(5)\n\t"
        "v_mfma_f32_32x32x16_bf16 %1, %3, %16, %1\n\t"
        "ds_read_b128 %3, %9 offset:4640\n\t"
        "s_waitcnt lgkmcnt(5)\n\t"
        "v_mfma_f32_32x32x16_bf16 %0, %4, %17, %0\n\t"
        "ds_read_b128 %4, %9 offset:64\n\t"
        "s_waitcnt lgkmcnt(5)\n\t"
        "v_mfma_f32_32x32x16_bf16 %1, %5, %17, %1\n\t"
        "ds_read_b128 %5, %9 offset:4672\n\t"
        "s_waitcnt lgkmcnt(5)\n\t"
        "v_mfma_f32_32x32x16_bf16 %0, %6, %18, %0\n\t"
        "ds_read_b128 %6, %9 offset:96\n\t"
        "s_waitcnt lgkmcnt(5)\n\t"
        "v_mfma_f32_32x32x16_bf16 %1, %7, %18, %1\n\t"
        "ds_read_b128 %7, %9 offset:4704\n\t"
        "s_waitcnt lgkmcnt(5)\n\t"
        "v_mfma_f32_32x32x16_bf16 %0, %2, %19, %0\n\t"
        "s_waitcnt lgkmcnt(4)\n\t"
        "v_mfma_f32_32x32x16_bf16 %1, %3, %19, %1\n\t"
        "s_waitcnt lgkmcnt(3)\n\t"
        "v_mfma_f32_32x32x16_bf16 %0, %4, %20, %0\n\t"
        "s_waitcnt lgkmcnt(2)\n\t"
        "v_mfma_f32_32x32x16_bf16 %1, %5, %20, %1\n\t"
        "s_waitcnt lgkmcnt(1)\n\t"
        "v_mfma_f32_32x32x16_bf16 %0, %6, %21, %0\n\t"
        "s_waitcnt lgkmcnt(0)\n\t"
        "v_mfma_f32_32x32x16_bf16 %1, %7, %21, %1\n\t"
        "s_nop 15\n\t"
        "s_nop 3\n\t"
        : "=&v"(S0), "=&v"(S1), "+v"(t.f0), "+v"(t.f1), "=&v"(f2), "=&v"(f3), "=&v"(f4), "=&v"(f5)
        : "v"(aN), "v"(aR), "v"(qf[0]), "v"(qf[1]), "v"(qf[2]), "v"(qf[3]), "v"(qf[4]), "v"(qf[5]), "v"(qf[6]), "v"(qf[7]), "v"(qf[8]), "v"(qf[9]), "v"(qf[10]), "v"(qf[11])
        : "memory");
}
struct PvFrag { bf16x8 f0, f1, f2, f3, f4, f5; };
__device__ __forceinline__ void pv_head(PvFrag& t, unsigned aV) {
    asm volatile(
        "ds_read_b128 %0, %6 offset:0\n\t"
        "ds_read_b128 %1, %6 offset:4608\n\t"
        "ds_read_b128 %2, %6 offset:9216\n\t"
        "ds_read_b128 %3, %6 offset:13824\n\t"
        "ds_read_b128 %4, %6 offset:32\n\t"
        "ds_read_b128 %5, %6 offset:4640\n\t"
        : "=&v"(t.f0), "=&v"(t.f1), "=&v"(t.f2), "=&v"(t.f3), "=&v"(t.f4), "=&v"(t.f5)
        : "v"(aV)
        : "memory");
}
__device__ __forceinline__ void pv_tail(f32x16 (&O)[4], PvFrag& t, unsigned aV, const bf16x8 (&pf)[4]) {
    asm volatile(
        "s_waitcnt lgkmcnt(5)\n\t"
        "v_mfma_f32_32x32x16_bf16 %0, %4, %11, %0\n\t"
        "ds_read_b128 %4, %10 offset:9248\n\t"
        "s_waitcnt lgkmcnt(5)\n\t"
        "v_mfma_f32_32x32x16_bf16 %1, %5, %11, %1\n\t"
        "ds_read_b128 %5, %10 offset:13856\n\t"
        "s_waitcnt lgkmcnt(5)\n\t"
        "v_mfma_f32_32x32x16_bf16 %2, %6, %11, %2\n\t"
        "ds_read_b128 %6, %10 offset:64\n\t"
        "s_waitcnt lgkmcnt(5)\n\t"
        "v_mfma_f32_32x32x16_bf16 %3, %7, %11, %3\n\t"
        "ds_read_b128 %7, %10 offset:4672\n\t"
        "s_waitcnt lgkmcnt(5)\n\t"
        "v_mfma_f32_32x32x16_bf16 %0, %8, %12, %0\n\t"
        "ds_read_b128 %8, %10 offset:9280\n\t"
        "s_waitcnt lgkmcnt(5)\n\t"
        "v_mfma_f32_32x32x16_bf16 %1, %9, %12, %1\n\t"
        "ds_read_b128 %9, %10 offset:13888\n\t"
        "s_waitcnt lgkmcnt(5)\n\t"
        "v_mfma_f32_32x32x16_bf16 %2, %4, %12, %2\n\t"
        "ds_read_b128 %4, %10 offset:96\n\t"
        "s_waitcnt lgkmcnt(5)\n\t"
        "v_mfma_f32_32x32x16_bf16 %3, %5, %12, %3\n\t"
        "ds_read_b128 %5, %10 offset:4704\n\t"
        "s_waitcnt lgkmcnt(5)\n\t"
        "v_mfma_f32_32x32x16_bf16 %0, %6, %13, %0\n\t"
        "ds_read_b128 %6, %10 offset:9312\n\t"
        "s_waitcnt lgkmcnt(5)\n\t"
        "v_mfma_f32_32x32x16_bf16 %1, %7, %13, %1\n\t"
        "ds_read_b128 %7, %10 offset:13920\n\t"
        "s_waitcnt lgkmcnt(5)\n\t"
        "v_mfma_f32_32x32x16_bf16 %2, %8, %13, %2\n\t"
        "s_waitcnt lgkmcnt(4)\n\t"
        "v_mfma_f32_32x32x16_bf16 %3, %9, %13, %3\n\t"
        "s_waitcnt lgkmcnt(3)\n\t"
        "v_mfma_f32_32x32x16_bf16 %0, %4, %14, %0\n\t"
        "s_waitcnt lgkmcnt(2)\n\t"
        "v_mfma_f32_32x32x16_bf16 %1, %5, %14, %1\n\t"
        "s_waitcnt lgkmcnt(1)\n\t"
        "v_mfma_f32_32x32x16_bf16 %2, %6, %14, %2\n\t"
        "s_waitcnt lgkmcnt(0)\n\t"
        "v_mfma_f32_32x32x16_bf16 %3, %7, %14, %3\n\t"
        "s_nop 15\n\t"
        "s_nop 3\n\t"
        : "+v"(O[0]), "+v"(O[1]), "+v"(O[2]), "+v"(O[3]), "+v"(t.f0), "+v"(t.f1), "+v"(t.f2), "+v"(t.f3), "+v"(t.f4), "+v"(t.f5)
        : "v"(aV), "v"(pf[0]), "v"(pf[1]), "v"(pf[2]), "v"(pf[3])
        : "memory");
}
constexpr int KB_BYTES = KN_BYTES + KR_BYTES, AB_V_OFF = 3 * KB_BYTES, AB_LDS_BYTES = AB_V_OFF + 2 * VT_BYTES, NP_K2 = NP_KN + NP_KR;
template <class BG>
__device__ __forceinline__ void unit_ab(LAS unsigned char* lds, const bf16* Q, const bf16* KN, const bf16* KR, const bf16* VT, bf16* MIX, int h, int qb, BG& bg) {
    int tid_ = threadIdx.x; asm volatile("" : "+v"(tid_));
    const int lane = tid_ & 63, wave = __builtin_amdgcn_readfirstlane(tid_ >> 6), c = lane & 31, hi = lane >> 5;
    const bool grpB = wave >= 4;
    const int q0 = qb * 256 + wave * 32, ntile = 4 * (qb + 1);
    const int xP = (wave == 0) ? 16 : (wave == 1) ? NP_KN + 8 : NP_K2 + 14 + wave;
    unsigned vK0 = piece_voff(2 * wave, lane), vK1 = piece_voff(2 * wave + 1, lane), vR = piece_voff(NP_KN + wave, lane), vV0 = piece_voff(NP_K2 + 2 * wave, lane), vV1 = piece_voff(NP_K2 + 2 * wave + 1, lane), vX = piece_voff(wave < 4 ? xP : 0, lane);
    const char* knb = (const char*)KN + (size_t)h * 256; const char* krb = (const char*)KR; const char* vtb = (const char*)VT + (size_t)h * 128 * (M * 2);
#define AB_DMA(gb, vo, loff) do { asm volatile("" : "+v"(vo));     \
        __builtin_amdgcn_global_load_lds((const unsigned*)((gb) + (vo)), (LAS unsigned*)(lds + (loff)), 16, 0, 0); } while (0)
#define AB_ISSUE_K(t, kofs) do { const size_t key0_ = (size_t)(t) * 64; const char* bn_ = knb + key0_ * 2048; const char* br_ = krb + key0_ * 128; const int lo_ = (kofs) + wave * 2048; \
        AB_DMA(bn_, vK0, lo_); AB_DMA(bn_, vK1, lo_ + 1024); AB_DMA(br_, vR, (kofs) + (NP_KN + wave) * 1024); \
        if (wave == 0) AB_DMA(bn_, vX, (kofs) + 16 * 1024); else if (wave == 1) AB_DMA(br_, vX, (kofs) + (NP_KN + 8) * 1024); } while (0)
#define AB_ISSUE_V(t, vofs) do { const char* bv_ = vtb + (size_t)(t) * 128; const int lo_ = AB_V_OFF + (vofs) + wave * 2048; \
        AB_DMA(bv_, vV0, lo_); AB_DMA(bv_, vV1, lo_ + 1024); \
        if (wave == 2 || wave == 3) AB_DMA(bv_, vX, AB_V_OFF + (vofs) + (14 + wave) * 1024); } while (0)
    bf16x8 qf[12];
    { const bf16* qrow = Q + (size_t)(q0 + c) * 1536 + h * 192 + 8 * hi;
#pragma unroll
      for (int ch = 0; ch < 12; ++ch) qf[ch] = *(const bf16x8*)(qrow + 16 * ch); }
    AB_ISSUE_K(0, 0); AB_ISSUE_V(0, 0); AB_ISSUE_K(1, KB_BYTES);
    f32x16 O[4];
#pragma unroll
    for (int d = 0; d < 4; ++d)
#pragma unroll
        for (int r = 0; r < 16; ++r) O[d][r] = 0.f;
    float m = -1e30f, l = 0.f;
    const int kn_l = c * KN_ROW + hi * 16, kr_l = c * KR_ROW + hi * 16, vt_l = c * VT_ROW + hi * 16;
    const unsigned ldsbase = (unsigned)(size_t)lds;
#define AB_QK(kofs_) qk_pipe(S0, S1, ldsbase + (unsigned)(kofs_) + (unsigned)kn_l, ldsbase + (unsigned)(kofs_) + (unsigned)(KN_BYTES + kr_l), qf)
#define AB_SMPV(key0_, vofs_) do { PvFrag vf_; const unsigned av_ = ldsbase + (unsigned)(AB_V_OFF + (vofs_)) + (unsigned)vt_l; pv_head(vf_, av_); \
        if ((key0_) + 63 > q0) { const int lim = q0 + c - (key0_) - 8 * hi; \
            _Pragma("unroll") for (int r = 0; r < 16; ++r) { const int ko = 16 * (r >> 3) + (r & 7); if (ko > lim) S0[r] = -__builtin_inff(); if (ko + 32 > lim) S1[r] = -__builtin_inff(); } } \
        float pm = S0[0]; \
        _Pragma("unroll") for (int r = 1; r < 16; ++r) pm = fmaxf(pm, S0[r]); \
        _Pragma("unroll") for (int r = 0; r < 16; ++r) pm = fmaxf(pm, S1[r]); \
        pm = xmax32(pm); \
        if (!__all(pm <= m + 8.0f)) { const float mn = fmaxf(m, pm), alpha = __builtin_amdgcn_exp2f(m - mn); m = mn; l *= alpha; \
            _Pragma("unroll") for (int d = 0; d < 4; ++d) _Pragma("unroll") for (int r = 0; r < 16; ++r) O[d][r] *= alpha; } \
        float ps = 0.f; \
        _Pragma("unroll") for (int r = 0; r < 16; ++r) { S0[r] = __builtin_amdgcn_exp2f(S0[r] - m); S1[r] = __builtin_amdgcn_exp2f(S1[r] - m); ps += S0[r] + S1[r]; } \
        l += ps; \
        bf16x8 pf[4]; \
        _Pragma("unroll") for (int s = 0; s < 2; ++s) { \
            u32x4 w0 = {cvtpk(S0[8 * s + 0], S0[8 * s + 1]), cvtpk(S0[8 * s + 2], S0[8 * s + 3]), cvtpk(S0[8 * s + 4], S0[8 * s + 5]), cvtpk(S0[8 * s + 6], S0[8 * s + 7])}; \
            u32x4 w1 = {cvtpk(S1[8 * s + 0], S1[8 * s + 1]), cvtpk(S1[8 * s + 2], S1[8 * s + 3]), cvtpk(S1[8 * s + 4], S1[8 * s + 5]), cvtpk(S1[8 * s + 6], S1[8 * s + 7])}; \
            pf[s] = __builtin_bit_cast(bf16x8, w0); pf[2 + s] = __builtin_bit_cast(bf16x8, w1); } \
        pv_tail(O, vf_, av_, pf); } while (0)
    asm volatile("s_waitcnt vmcnt(0)" ::: "memory"); __syncthreads();
    f32x16 S0, S1;
    KFrag kf;
    int kc0 = 0, kc2 = 2 * KB_BYTES, kc1 = KB_BYTES;
#define AB_SYNC(i) do { \
        if (bg.nfly) asm volatile("s_waitcnt vmcnt(4)" ::: "memory"); else asm volatile("s_waitcnt vmcnt(0)" ::: "memory"); \
        asm volatile("" ::: "memory"); asm volatile("s_waitcnt lgkmcnt(0)" ::: "memory"); __builtin_amdgcn_s_barrier(); asm volatile("" ::: "memory"); } while (0)
#define AB_FEED(i) do { \
        if ((i) + 2 < ntile) AB_ISSUE_K((i) + 2, kc2); \
        if ((i) + 1 < ntile) AB_ISSUE_V((i) + 1, (((i) + 1) & 1) * VT_BYTES); } while (0)
#define AB_BG(i) do { bg.pre(i); bg.post(i); } while (0)
    for (int j = 0; j < ntile; ++j) {
        const int key0 = j * 64; const bool act = key0 <= q0 + 31;
        if (!grpB) AB_SYNC(j);
        if (act) { if (grpB && j > 0) qk_tail(S0, S1, kf, ldsbase + (unsigned)kc0 + (unsigned)kn_l, ldsbase + (unsigned)kc0 + (unsigned)(KN_BYTES + kr_l), qf); else AB_QK(kc0); }
        if (grpB) AB_SYNC(j);
        AB_FEED(j);
        if (!grpB) AB_BG(j);
        if (act) AB_SMPV(key0, (j & 1) * VT_BYTES);
        if (grpB) { if (j + 1 < ntile && key0 + 64 <= q0 + 31) qk_head(kf, ldsbase + (unsigned)kc1 + (unsigned)kn_l);
            AB_BG(j); }
        { const int t = kc0; kc0 = kc1; kc1 = kc2; kc2 = t; }
    }
    if (bg.nfly) asm volatile("s_waitcnt vmcnt(4)" ::: "memory"); else asm volatile("s_waitcnt vmcnt(0)" ::: "memory");
    asm volatile("" ::: "memory"); asm volatile("s_waitcnt lgkmcnt(0)" ::: "memory"); __builtin_amdgcn_s_barrier(); asm volatile("" ::: "memory");
#undef AB_SYNC
#undef AB_FEED
#undef AB_BG
    const float il = 1.0f / xsum32(l);
    bf16* orow = MIX + (size_t)(q0 + c) * DM + 3072 + h * 128 + 4 * hi;
#pragma unroll
    for (int d = 0; d < 4; ++d)
#pragma unroll
        for (int g = 0; g < 4; ++g) { u32x2 w = {cvtpk(O[d][4 * g + 0] * il, O[d][4 * g + 1] * il), cvtpk(O[d][4 * g + 2] * il, O[d][4 * g + 3] * il)};
            *(u32x2*)(orow + 32 * d + 8 * g) = w; }
#undef AB_ISSUE_K
#undef AB_DMA
#undef AB_ISSUE_V
#undef AB_QK
#undef AB_SMPV
}
static_assert(AB_LDS_BYTES + 3 * 4224 <= 131072, "mla two-group LDS map");
}
namespace dil {
typedef float f32x16 __attribute__((ext_vector_type(16)));
typedef short bf16x8 __attribute__((ext_vector_type(8)));
typedef short s16x4 __attribute__((ext_vector_type(4)));
typedef unsigned u32x4 __attribute__((ext_vector_type(4)));
typedef unsigned u32x2 __attribute__((ext_vector_type(2)));
constexpr int K_ROW = 272, K_BYTES = 64 * K_ROW, V_BYTES = 64 * 256, BUF_BYTES = K_BYTES + V_BYTES, NP_K = K_BYTES / 1024, NP_V = V_BYTES / 1024, NPIECE = NP_K + NP_V;
constexpr int TAB_OFF = 3 * BUF_BYTES;
static_assert(NP_K * 1024 == K_BYTES && TAB_OFF + 1024 <= 131072, "dil LDS map");
constexpr float LOG2E = 1.4426950408889634f;

__device__ __forceinline__ unsigned piece_voff(int P, int lane, unsigned dstride) {
    if (P < NP_K) { const int s = 64 * P + lane, rho = s / 17; int ch = s - rho * 17; if (ch == 16) ch = 0; const int keyl = (rho & 32) | mla::swap23(rho & 31); return (unsigned)keyl * dstride + (unsigned)(ch * 16); }
    { const int row = 4 * (P - NP_K) + (lane >> 4), chp = lane & 15, ch = chp ^ (((row & 3) << 2) | ((row >> 2) & 3)); return (unsigned)row * dstride + (unsigned)(ch * 16); }
}

__device__ __forceinline__ void qk_pipe(f32x16& S0, f32x16& S1, unsigned a, const bf16x8 (&qf)[8]) {
    bf16x8 f0, f1, f2, f3, f4, f5;
    asm volatile(
        "ds_read_b128 %2, %8 offset:0\n\t"
        "ds_read_b128 %3, %8 offset:8704\n\t"
        "ds_read_b128 %4, %8 offset:32\n\t"
        "ds_read_b128 %5, %8 offset:8736\n\t"
        "ds_read_b128 %6, %8 offset:64\n\t"
        "ds_read_b128 %7, %8 offset:8768\n\t"
        "s_waitcnt lgkmcnt(5)\n\t"
        "v_mfma_f32_32x32x16_bf16 %0, %2, %9, 0\n\t"
        "ds_read_b128 %2, %8 offset:96\n\t"
        "s_waitcnt lgkmcnt(5)\n\t"
        "v_mfma_f32_32x32x16_bf16 %1, %3, %9, 0\n\t"
        "ds_read_b128 %3, %8 offset:8800\n\t"
        "s_waitcnt lgkmcnt(5)\n\t"
        "v_mfma_f32_32x32x16_bf16 %0, %4, %10, %0\n\t"
        "ds_read_b128 %4, %8 offset:128\n\t"
        "s_waitcnt lgkmcnt(5)\n\t"
        "v_mfma_f32_32x32x16_bf16 %1, %5, %10, %1\n\t"
        "ds_read_b128 %5, %8 offset:8832\n\t"
        "s_waitcnt lgkmcnt(5)\n\t"
        "v_mfma_f32_32x32x16_bf16 %0, %6, %11, %0\n\t"
        "ds_read_b128 %6, %8 offset:160\n\t"
        "s_waitcnt lgkmcnt(5)\n\t"
        "v_mfma_f32_32x32x16_bf16 %1, %7, %11, %1\n\t"
        "ds_read_b128 %7, %8 offset:8864\n\t"
        "s_waitcnt lgkmcnt(5)\n\t"
        "v_mfma_f32_32x32x16_bf16 %0, %2, %12, %0\n\t"
        "ds_read_b128 %2, %8 offset:192\n\t"
        "s_waitcnt lgkmcnt(5)\n\t"
        "v_mfma_f32_32x32x16_bf16 %1, %3, %12, %1\n\t"
        "ds_read_b128 %3, %8 offset:8896\n\t"
        "s_waitcnt lgkmcnt(5)\n\t"
        "v_mfma_f32_32x32x16_bf16 %0, %4, %13, %0\n\t"
        "ds_read_b128 %4, %8 offset:224\n\t"
        "s_waitcnt lgkmcnt(5)\n\t"
        "v_mfma_f32_32x32x16_bf16 %1, %5, %13, %1\n\t"
        "ds_read_b128 %5, %8 offset:8928\n\t"
        "s_waitcnt lgkmcnt(5)\n\t"
        "v_mfma_f32_32x32x16_bf16 %0, %6, %14, %0\n\t"
        "s_waitcnt lgkmcnt(4)\n\t"
        "v_mfma_f32_32x32x16_bf16 %1, %7, %14, %1\n\t"
        "s_waitcnt lgkmcnt(3)\n\t"
        "v_mfma_f32_32x32x16_bf16 %0, %2, %15, %0\n\t"
        "s_waitcnt lgkmcnt(2)\n\t"
        "v_mfma_f32_32x32x16_bf16 %1, %3, %15, %1\n\t"
        "s_waitcnt lgkmcnt(1)\n\t"
        "v_mfma_f32_32x32x16_bf16 %0, %4, %16, %0\n\t"
        "s_waitcnt lgkmcnt(0)\n\t"
        "v_mfma_f32_32x32x16_bf16 %1, %5, %16, %1\n\t"
        "s_nop 15\n\t"
        "s_nop 3\n\t"
        : "=&v"(S0), "=&v"(S1), "=&v"(f0), "=&v"(f1), "=&v"(f2), "=&v"(f3), "=&v"(f4), "=&v"(f5)
        : "v"(a), "v"(qf[0]), "v"(qf[1]), "v"(qf[2]), "v"(qf[3]), "v"(qf[4]), "v"(qf[5]), "v"(qf[6]), "v"(qf[7])
        : "memory");
}
__device__ __forceinline__ void unit(LAS unsigned char* lds, const bf16* PROJ, const float* BIAS, float* DSO, float* DSML, bf16* MIX, int b, int r, int h, int nb) {
    int tid_ = threadIdx.x; asm volatile("" : "+v"(tid_));
    const int lane = tid_ & 63, wave = __builtin_amdgcn_readfirstlane(tid_ >> 6), c = lane & 31, hi = lane >> 5;
    const int d = 1 << (2 * b); const unsigned dstride = (unsigned)d * (INWP * 2);
    if (tid_ < 256) { const int dist = tid_ - 64; ((LAS float*)(lds + TAB_OFF))[tid_] = (dist >= 0 && dist <= 128) ? BIAS[(b * 129 + dist) * 8 + h] * LOG2E : -__builtin_inff(); }
    unsigned voff[5];
#pragma unroll
    for (int k = 0; k < 5; ++k) voff[k] = piece_voff((wave + 8 * k) < NPIECE ? (wave + 8 * k) : 0, lane, dstride);
    const char* kg = (const char*)PROJ + ((size_t)r * INWP + C_K + h * 128) * 2; const char* vg = (const char*)PROJ + ((size_t)r * INWP + C_V + h * 128) * 2;
#define DIL_ISSUE(kt, bufb) do { const size_t tb_ = (size_t)(kt) * 64 * dstride; \
        _Pragma("unroll") for (int k = 0; k < 5; ++k) { const int P = wave + 8 * k; if (P < NPIECE) { \
            const char* gb = ((P < NP_K) ? kg : vg) + tb_; asm volatile("" : "+v"(voff[k])); \
            __builtin_amdgcn_global_load_lds((const unsigned*)(gb + voff[k]), (LAS unsigned*)(lds + (bufb) + P * 1024), 16, 0, 0); } } } while (0)
    const int nq = 256 * nb + 32 * wave + c;
    const size_t tokq = (size_t)nq * d + r;
    bf16x8 qf[8];
    { const bf16* qrow = PROJ + tokq * INWP + C_Q + h * 128 + 8 * hi;
#pragma unroll
      for (int ch = 0; ch < 8; ++ch) qf[ch] = *(const bf16x8*)(qrow + 16 * ch); }
    const int kt0 = (4 * nb - 2) > 0 ? (4 * nb - 2) : 0, kt1 = 4 * nb + 3;
    DIL_ISSUE(kt0, 0);
    f32x16 O[4]; float m, l;
    bf16* so = (bf16*)DSO + (tokq * 8 + h) * 128 + 4 * hi; float* sml = DSML + (tokq * 8 + h) * 2;
    if (b == 0) {
#pragma unroll
        for (int q4 = 0; q4 < 4; ++q4)
#pragma unroll
            for (int i = 0; i < 16; ++i) O[q4][i] = 0.f;
        m = -1e30f; l = 0.f;
    } else {
#pragma unroll
        for (int q4 = 0; q4 < 4; ++q4)
#pragma unroll
            for (int g = 0; g < 4; ++g) { const u32x2 v = *(const u32x2*)(so + 32 * q4 + 8 * g); O[q4][4 * g + 0] = bflo(v.x); O[q4][4 * g + 1] = bfhi(v.x); O[q4][4 * g + 2] = bflo(v.y); O[q4][4 * g + 3] = bfhi(v.y); }
        m = sml[0]; l = hi ? 0.f : sml[1];
    }
    const int k_l = c * K_ROW + hi * 16;
    unsigned vt[2];
    { const int blk = (lane >> 4) & 1, q = (lane & 15) >> 2, p = lane & 3;
#pragma unroll
      for (int t = 0; t < 2; ++t) vt[t] = (unsigned)(256 * (8 * hi + 4 * t + q) + 16 * ((q << 2) | ((2 * blk + (p >> 1)) ^ (2 * hi + t))) + 8 * (p & 1)); }
    const unsigned ldsbase = (unsigned)(size_t)lds;
    DIL_ISSUE(kt0 + 1, BUF_BYTES);
    asm volatile("s_waitcnt vmcnt(4)" ::: "memory"); asm volatile("s_waitcnt lgkmcnt(0)" ::: "memory"); __builtin_amdgcn_s_barrier(); asm volatile("" ::: "memory");
    const float SC = DIL_SCALE * LOG2E;
    int bufb = 0, bufn = 2 * BUF_BYTES;
    for (int kt = kt0; kt <= kt1; ++kt) {
        if (kt + 2 <= kt1) DIL_ISSUE(kt + 2, bufn);
        const int klo = 4 * nb + (wave >> 1) - 2;
        if (kt >= klo && kt <= klo + 2) {
            f32x16 S0, S1;
            qk_pipe(S0, S1, ldsbase + (unsigned)bufb + (unsigned)k_l, qf);
            { const int dbase = nq - 64 * kt - 8 * hi + 64;
              const LAS float* tp = (const LAS float*)(lds + TAB_OFF) + (dbase - 63);
#pragma unroll
              for (int i = 0; i < 16; ++i) { const int cr = 16 * (i >> 3) + (i & 7); S0[i] = S0[i] * SC + tp[63 - cr]; S1[i] = S1[i] * SC + tp[63 - cr - 32]; } }
            float pm = S0[0];
#pragma unroll
            for (int i = 1; i < 16; ++i) pm = fmaxf(pm, S0[i]);
#pragma unroll
            for (int i = 0; i < 16; ++i) pm = fmaxf(pm, S1[i]);
            pm = mla::xmax32(pm);
            if (!__all(pm <= m + 8.0f)) {
                const float mn = fmaxf(m, pm), alpha = __builtin_amdgcn_exp2f(m - mn); m = mn; l *= alpha;
#pragma unroll
                for (int q4 = 0; q4 < 4; ++q4)
#pragma unroll
                    for (int i = 0; i < 16; ++i) O[q4][i] *= alpha;
            }
            float ps = 0.f;
#pragma unroll
            for (int i = 0; i < 16; ++i) { S0[i] = __builtin_amdgcn_exp2f(S0[i] - m); S1[i] = __builtin_amdgcn_exp2f(S1[i] - m); ps += S0[i] + S1[i]; }
            l += ps;
            bf16x8 pf[4];
#pragma unroll
            for (int s = 0; s < 2; ++s) {
                u32x4 w0 = {mla::cvtpk(S0[8 * s + 0], S0[8 * s + 1]), mla::cvtpk(S0[8 * s + 2], S0[8 * s + 3]), mla::cvtpk(S0[8 * s + 4], S0[8 * s + 5]), mla::cvtpk(S0[8 * s + 6], S0[8 * s + 7])};
                u32x4 w1 = {mla::cvtpk(S1[8 * s + 0], S1[8 * s + 1]), mla::cvtpk(S1[8 * s + 2], S1[8 * s + 3]), mla::cvtpk(S1[8 * s + 4], S1[8 * s + 5]), mla::cvtpk(S1[8 * s + 6], S1[8 * s + 7])};
                pf[s] = __builtin_bit_cast(bf16x8, w0); pf[2 + s] = __builtin_bit_cast(bf16x8, w1); }
            const unsigned vb = ldsbase + (unsigned)bufb + K_BYTES;
            const unsigned a00 = vb + vt[0], a01 = vb + vt[1], a10 = vb + (vt[0] ^ 64u), a11 = vb + (vt[1] ^ 64u), a20 = vb + (vt[0] ^ 128u), a21 = vb + (vt[1] ^ 128u), a30 = vb + (vt[0] ^ 192u), a31 = vb + (vt[1] ^ 192u);
#define DIL_PV(kc) do { s16x4 r00, r01, r10, r11, r20, r21, r30, r31; \
            asm volatile("ds_read_b64_tr_b16 %0, %8 offset:%16\n\tds_read_b64_tr_b16 %1, %9 offset:%16\n\tds_read_b64_tr_b16 %2, %10 offset:%16\n\tds_read_b64_tr_b16 %3, %11 offset:%16\n\t" \
                         "ds_read_b64_tr_b16 %4, %12 offset:%16\n\tds_read_b64_tr_b16 %5, %13 offset:%16\n\tds_read_b64_tr_b16 %6, %14 offset:%16\n\tds_read_b64_tr_b16 %7, %15 offset:%16\n\ts_waitcnt lgkmcnt(0)" \
                         : "=&v"(r00), "=&v"(r01), "=&v"(r10), "=&v"(r11), "=&v"(r20), "=&v"(r21), "=&v"(r30), "=&v"(r31) \
                         : "v"(a00), "v"(a01), "v"(a10), "v"(a11), "v"(a20), "v"(a21), "v"(a30), "v"(a31), "n"(4096 * (kc)) : "memory"); \
            O[0] = __builtin_amdgcn_mfma_f32_32x32x16_bf16(__builtin_shufflevector(r00, r01, 0, 1, 2, 3, 4, 5, 6, 7), pf[kc], O[0], 0, 0, 0); \
            O[1] = __builtin_amdgcn_mfma_f32_32x32x16_bf16(__builtin_shufflevector(r10, r11, 0, 1, 2, 3, 4, 5, 6, 7), pf[kc], O[1], 0, 0, 0); \
            O[2] = __builtin_amdgcn_mfma_f32_32x32x16_bf16(__builtin_shufflevector(r20, r21, 0, 1, 2, 3, 4, 5, 6, 7), pf[kc], O[2], 0, 0, 0); \
            O[3] = __builtin_amdgcn_mfma_f32_32x32x16_bf16(__builtin_shufflevector(r30, r31, 0, 1, 2, 3, 4, 5, 6, 7), pf[kc], O[3], 0, 0, 0); } while (0)
            DIL_PV(0); DIL_PV(1); DIL_PV(2); DIL_PV(3);
#undef DIL_PV
        }
        if (kt + 2 <= kt1) asm volatile("s_waitcnt vmcnt(4)" ::: "memory"); else asm volatile("s_waitcnt vmcnt(0)" ::: "memory");
        asm volatile("s_waitcnt lgkmcnt(0)" ::: "memory"); __builtin_amdgcn_s_barrier(); asm volatile("" ::: "memory");
        { const int t = bufb + BUF_BYTES; bufn = bufb; bufb = (t == 3 * BUF_BYTES) ? 0 : t; }
    }
    const float lt = mla::xsum32(l);
    if (b == 2) {
        const float il = 1.0f / lt;
        bf16* orow = MIX + tokq * DM + 1024 + h * 128 + 4 * hi;
#pragma unroll
        for (int q4 = 0; q4 < 4; ++q4)
#pragma unroll
            for (int g = 0; g < 4; ++g) { u32x2 w = {mla::cvtpk(O[q4][4 * g + 0] * il, O[q4][4 * g + 1] * il), mla::cvtpk(O[q4][4 * g + 2] * il, O[q4][4 * g + 3] * il)};
                *(u32x2*)(orow + 32 * q4 + 8 * g) = w; }
    } else {
#pragma unroll
        for (int q4 = 0; q4 < 4; ++q4)
#pragma unroll
            for (int g = 0; g < 4; ++g) { u32x2 v = {mla::cvtpk(O[q4][4 * g + 0], O[q4][4 * g + 1]), mla::cvtpk(O[q4][4 * g + 2], O[q4][4 * g + 3])}; *(u32x2*)(so + 32 * q4 + 8 * g) = v; }
        if (hi == 0) { sml[0] = m; sml[1] = lt; }
    }
#undef DIL_ISSUE
}
__device__ __forceinline__ void pass(LAS unsigned char* lds, const bf16* PROJ, const float* BIAS, float* DSO, float* DSML, bf16* MIX, int b) {
    for (int u = blockIdx.x; u < 512; u += gridDim.x) { const int h = u & 7, rest = u >> 3, d = 1 << (2 * b), r = rest & (d - 1), nb = rest >> (2 * b);
        unit(lds, PROJ, BIAS, DSO, DSML, MIX, b, r, h, nb); }
}
}
struct Args { const float* in[18]; float* out; unsigned char* ws; float inv[32]; int ph_lo, ph_hi; };
static_assert(sizeof(Args) == 18 * 8 + 8 + 8 + 32 * 4 + 8, "Args has no padding");

__device__ __forceinline__ void p0_prologue(const __attribute__((address_space(4))) Args* ap, LAS unsigned char* lds, int gw, int NGW, int wave, int lane) {
    const __attribute__((address_space(4))) Args& a = *ap;
    unsigned char* ws = a.ws;
    LAS float* scr = (LAS float*)(lds + RING_OFF + wave * 16384);
    constexpr int I_IN = 64 * 266, I_POOL = 4 * 4 * 8, I_UQ = 12 * 48, I_UKV = 8 * 64, I_OUT = 64 * 128, I_G = 64 * 344, I_DN = 172 * 128;
    constexpr int I_LAYER = I_IN + I_POOL + I_UQ + I_UKV + I_OUT + 2 * I_G + I_DN;
    constexpr int I_SMALL = I_POOL + I_UQ + I_UKV;
    for (int it = gw; it < (MK_MLA_CONV ? I_IN + DEPTH * I_SMALL : DEPTH * I_LAYER); it += NGW) {
        int l, r;
        if (MK_MLA_CONV) { if (it < I_IN) { l = 0; r = it; } else { const int q = it - I_IN; l = q / I_SMALL; r = I_IN + (q - l * I_SMALL); } }
        else { l = it / I_LAYER; r = it - l * I_LAYER; }
        unsigned char* wl = ws + WS_W + (size_t)l * W_LAYER;
        if (r < I_IN) { const int kb = r / 266, nb = r % 266; tr_item(a.in[1] + (size_t)l * DM * INW, INW, kb * 64, nb * 32, (bf16*)(wl + W_IN), DM, nb * 32, 1, nullptr, nullptr, scr, lane, DM / 64); continue; } r -= I_IN;
        if (r < I_POOL) { const int g = r / 32, q = r % 32, kb = q / 8, nb = q % 8;
            tr_item(a.in[2] + (size_t)(l * 4 + g) * 65536, 256, kb * 64, nb * 32, (bf16*)(wl + W_POOL), 256, g * 256 + nb * 32, 1, nullptr, a.in[3] + l * 1024 + g * 256, scr, lane, 256 / 64); continue; } r -= I_POOL;
        if (r < I_UQ) { const int kb = r / 48, nb = r % 48, n0 = nb * 32, h = n0 / 192, w = n0 % 192;
            const int orow0 = (w < 128) ? n0 : (h * 192 + 128 + (w == 128 ? 0 : 1)), ostr = (w < 128) ? 1 : 2;
            tr_item(a.in[7] + (size_t)l * QRANK * 1536, 1536, kb * 64, n0, (bf16*)(wl + W_UQ), QRANK, orow0, ostr, a.in[6] + l * QRANK, nullptr, scr, lane, QRANK / 64); continue; } r -= I_UQ;
        if (r < I_UKV) { const int kb = r / 64, nb = r % 64, n0 = nb * 32, h = n0 / 256, w = n0 % 256;
            bf16* dst = (bf16*)(wl + (w < 128 ? W_UK : W_UV));
            tr_item(a.in[9] + (size_t)l * KVRANK * 2048, 2048, kb * 64, n0, dst, KVRANK, h * 128 + (w & 127), 1, a.in[8] + l * KVRANK, nullptr, scr, lane, (w < 128 ? KVRANK / 64 : 0)); continue; } r -= I_UKV;
        if (r < I_OUT) { const int kb = r / 128, nb = r % 128; tr_item(a.in[10] + (size_t)l * DM * DM, DM, kb * 64, nb * 32, (bf16*)(wl + W_OUT), DM, nb * 32, 1, nullptr, nullptr, scr, lane, DM / 64); continue; } r -= I_OUT;
        if (r < 2 * I_G) { const int up = r >= I_G; if (up) r -= I_G; const int kb = r / 344, nb = r % 344, n0 = nb * 32;
            tr_item(a.in[up ? 14 : 13] + (size_t)l * DM * FFN, FFN, kb * 64, n0, (bf16*)(wl + W_GU), DM, (n0 >> 7) * 256 + (up ? 128 : 0) + (n0 & 127), 1, nullptr, nullptr, scr, lane, DM / 64); continue; } r -= 2 * I_G;
        { const int kb = r / 128, nb = r % 128; tr_item(a.in[15] + (size_t)l * FFN * DM, DM, kb * 64, nb * 32, (bf16*)(wl + W_DN), FFN, nb * 32, 1, nullptr, nullptr, scr, lane, FFN / 64); }
    }
    const int gt = gw * 64 + lane, NT = NGW * 64;
    for (int i = gt; i < DEPTH * 64 * 192 * 8; i += NT) { const int l = i / (64 * 192 * 8), r = i % (64 * 192 * 8), kt = r / (192 * 8), q = r % (192 * 8);
        *(v4u*)(ws + WS_W + (size_t)l * W_LAYER + W_IN + ((size_t)(33 * 64 + kt) * 256 + 64) * 128 + (size_t)q * 16) = (v4u){0u, 0u, 0u, 0u}; }
    for (int i = gt; i < M * DM / 8; i += NT) { const f32x4 v0 = *(const f32x4*)(a.in[0] + (size_t)i * 8), v1 = *(const f32x4*)(a.in[0] + (size_t)i * 8 + 4);
        v4u o; o.x = pk2(v0[0], v0[1]); o.y = pk2(v0[2], v0[3]); o.z = pk2(v1[0], v1[1]); o.w = pk2(v1[2], v1[3]); *(v4u*)(ws + WS_XB + (size_t)i * 16) = o; }
    for (int i = gt; i < M * 32; i += NT) { const int t = i >> 5, j = i & 31; const float ang = (float)t * a.inv[j]; float s, c; sincos_acc(ang, s, c);
        ((float*)(ws + WS_COS))[i] = c; ((float*)(ws + WS_SIN))[i] = s; }
    for (int i = gt; i < 3 * 129 * 8; i += NT) ((float*)(ws + WS_BIAS))[i] = a.in[4][(int)T5_BUCKET[i >> 3] * 8 + (i & 7)];
}

constexpr int CV_ITEMS_PER_LAYER = 64 * 266 + 4 * 4 * 8 + 12 * 48 + 8 * 64 + 64 * 128 + 2 * 64 * 344 + 172 * 128;
constexpr int CV_EARLY = 64 * 266, CV_LATE = 64 * 128 + 2 * 64 * 344 + 172 * 128;
struct CvDesc { const float* src; bf16* wb; int N; };
__device__ __forceinline__ CvDesc cv_decode(const __attribute__((address_space(4))) Args& a, int l, int h2) {
    constexpr int I_OUT = 64 * 128, I_G = 64 * 344;
    const bool late = h2 < 2 * CV_LATE; if (!late) { h2 -= 2 * CV_LATE; l += 1; }
    int r = h2 >> 1; const int kh = (h2 & 1) * 32; unsigned char* wl = a.ws + WS_W + (size_t)l * W_LAYER;
    const float* W; int N, kb, nb, orow0, nkt = DM / 64; bf16* WT;
    if (!late) { kb = r / 266; nb = r % 266; W = a.in[1] + (size_t)l * DM * INW; N = INW; WT = (bf16*)(wl + W_IN); orow0 = nb * 32; }
    else if (r < I_OUT) { kb = r / 128; nb = r % 128; W = a.in[10] + (size_t)l * DM * DM; N = DM; WT = (bf16*)(wl + W_OUT); orow0 = nb * 32; }
    else if ((r -= I_OUT) < 2 * I_G) { const int up = r >= I_G; if (up) r -= I_G; kb = r / 344; nb = r % 344; const int n0 = nb * 32; W = a.in[up ? 14 : 13] + (size_t)l * DM * FFN; N = FFN; WT = (bf16*)(wl + W_GU); orow0 = (n0 >> 7) * 256 + (up ? 128 : 0) + (n0 & 127); }
    else { r -= 2 * I_G; kb = r / 128; nb = r % 128; W = a.in[15] + (size_t)l * FFN * DM; N = DM; WT = (bf16*)(wl + W_DN); orow0 = nb * 32; nkt = FFN / 64; }
    const int k0 = kb * 64 + kh;
    CvDesc d; d.src = W + (size_t)k0 * N + nb * 32; d.N = N; d.wb = WT + (((size_t)((orow0 >> 8) * nkt + (k0 >> 6)) * 256 + (orow0 & 255)) * 64 + (k0 & 63)); return d;
}
struct ConvBg {
    const __attribute__((address_space(4))) Args* ka; LAS unsigned char* slot; int lane, l, next, stride, end, pend;
    CvDesc cd;
    __device__ __forceinline__ void issue(int h2) { cd = cv_decode(*ka, l, h2);
        unsigned vo = ((unsigned)(lane >> 3) * (unsigned)cd.N + 4u * (unsigned)(lane & 7)) * 4u;
#pragma unroll
        for (int i = 0; i < 4; ++i) { asm volatile("" : "+v"(vo)); __builtin_amdgcn_global_load_lds((const unsigned*)((const char*)(cd.src + (size_t)(8 * i) * cd.N) + vo), (LAS unsigned*)(slot + i * 1056), 16, 0, 0); } }
    __device__ __forceinline__ void finish() { const int c = lane & 3; const LAS float* sf = (const LAS float*)slot; bf16* wb = cd.wb;
#pragma unroll
        for (int j = 0; j < 2; ++j) { const int n = (lane >> 2) + 16 * j; const LAS float* s = sf + c * 264 + n;
            v4u o; o.x = mla::cvtpk(s[0], s[32]); o.y = mla::cvtpk(s[64], s[96]); o.z = mla::cvtpk(s[128], s[160]); o.w = mla::cvtpk(s[192], s[224]);
            unsigned lo = (unsigned)(n * 64 + 8 * c) * 2u; asm volatile("" : "+v"(lo));
            *(v4u*)((char*)wb + lo) = o; } }
    int nfly;
    __device__ __forceinline__ void pre(int j) { nfly = 0; if (j & 1) return; if (pend >= 0) { finish(); pend = -1; } asm volatile("s_waitcnt lgkmcnt(0)" ::: "memory"); }
    __device__ __forceinline__ void post(int j) { if (j & 1) return; if (next < end) { issue(next); pend = next; next += stride; nfly = 4; } }
    __device__ __forceinline__ void drain() {
        asm volatile("s_waitcnt vmcnt(0)" ::: "memory");
        if (pend >= 0) { finish(); pend = -1; }
        while (next < end) { asm volatile("s_waitcnt lgkmcnt(0)" ::: "memory"); issue(next); asm volatile("s_waitcnt vmcnt(0)" ::: "memory"); finish(); next += stride; }
    }
};

#define PREP_ACC8(S, V, SGN) do { S[0] += SGN bflo(V.x); S[1] += SGN bfhi(V.x); S[2] += SGN bflo(V.y); S[3] += SGN bfhi(V.y); S[4] += SGN bflo(V.z); S[5] += SGN bfhi(V.z); S[6] += SGN bflo(V.w); S[7] += SGN bfhi(V.w); } while (0)
template <int HH> __device__ __forceinline__ void prep_pool8(const bf16* PROJ, bf16* PD, int t0, int lane) {
    const int cg = lane + 64 * HH, col = cg * 8, w = 2 << (cg >> 5);
    const bf16* base = PROJ + (size_t)t0 * INWP + C_U + col;
    float s[8];
#pragma unroll
    for (int j = 0; j < 8; ++j) s[j] = 0.f;
    { constexpr int WMAX = HH ? 16 : 4; const int cnt = (t0 + 1 < w) ? t0 + 1 : w; v4u r[WMAX];
#pragma unroll
      for (int i = 0; i < WMAX; ++i) r[i] = (i < cnt) ? *(const v4u*)(base - (size_t)i * INWP) : (v4u){0u, 0u, 0u, 0u};
#pragma unroll
      for (int i = 0; i < WMAX; ++i) PREP_ACC8(s, r[i], +); }
    v4u un[8], uo[7];
    un[0] = *(const v4u*)base;
#pragma unroll
    for (int i = 1; i < 8; ++i) { un[i] = *(const v4u*)(base + (size_t)i * INWP); uo[i - 1] = (t0 + i - w >= 0) ? *(const v4u*)(base + (size_t)(i - w) * INWP) : (v4u){0u, 0u, 0u, 0u}; }
    v4u o[8];
#pragma unroll
    for (int i = 0; i < 8; ++i) { const int t = t0 + i;
        if (i > 0) { PREP_ACC8(s, un[i], +); PREP_ACC8(s, uo[i - 1], -); }
        const float ic = 1.0f / (float)((t + 1 < w) ? t + 1 : w); const v4u u = un[i];
        o[i].x = pk2(s[0] * ic - bflo(u.x), s[1] * ic - bfhi(u.x)); o[i].y = pk2(s[2] * ic - bflo(u.y), s[3] * ic - bfhi(u.y));
        o[i].z = pk2(s[4] * ic - bflo(u.z), s[5] * ic - bfhi(u.z)); o[i].w = pk2(s[6] * ic - bflo(u.w), s[7] * ic - bfhi(u.w)); }
    asm volatile("" ::: "memory");
#pragma unroll
    for (int i = 0; i < 8; ++i) *(v4u*)(PD + (size_t)(t0 + i) * 1024 + col) = o[i];
}
template <int HH> __device__ __forceinline__ void prep_conv8(const bf16* PROJ, bf16* MIX, const float* convw, int t0, int lane) {
    const int col = (lane + 64 * HH) * 8;
    f32x4 wt[3][2];
#pragma unroll
    for (int tap = 0; tap < 3; ++tap) { wt[tap][0] = *(const f32x4*)(convw + tap * 1024 + col); wt[tap][1] = *(const f32x4*)(convw + tap * 1024 + col + 4); }
    float zp[2][8];
#pragma unroll
    for (int q = 0; q < 2; ++q) { const int t = t0 - 2 + q;
        if (t >= 0) { const bf16* pr = PROJ + (size_t)t * INWP; const v4u hv = *(const v4u*)(pr + C_H + col), cv = *(const v4u*)(pr + C_C + col);
            zp[q][0] = bflo(cv.x) * bflo(hv.x); zp[q][1] = bfhi(cv.x) * bfhi(hv.x); zp[q][2] = bflo(cv.y) * bflo(hv.y); zp[q][3] = bfhi(cv.y) * bfhi(hv.y);
            zp[q][4] = bflo(cv.z) * bflo(hv.z); zp[q][5] = bfhi(cv.z) * bfhi(hv.z); zp[q][6] = bflo(cv.w) * bflo(hv.w); zp[q][7] = bfhi(cv.w) * bfhi(hv.w); }
        else {
#pragma unroll
            for (int j = 0; j < 8; ++j) zp[q][j] = 0.f; } }
#pragma unroll
    for (int half = 0; half < 2; ++half) {
        v4u hv[4], cv[4], bv[4], o[4];
#pragma unroll
        for (int i = 0; i < 4; ++i) { const bf16* pr = PROJ + (size_t)(t0 + 4 * half + i) * INWP; hv[i] = *(const v4u*)(pr + C_H + col); cv[i] = *(const v4u*)(pr + C_C + col); bv[i] = *(const v4u*)(pr + C_B + col); }
#pragma unroll
        for (int i = 0; i < 4; ++i) { float z[8], y[8];
            z[0] = bflo(cv[i].x) * bflo(hv[i].x); z[1] = bfhi(cv[i].x) * bfhi(hv[i].x); z[2] = bflo(cv[i].y) * bflo(hv[i].y); z[3] = bfhi(cv[i].y) * bfhi(hv[i].y);
            z[4] = bflo(cv[i].z) * bflo(hv[i].z); z[5] = bfhi(cv[i].z) * bfhi(hv[i].z); z[6] = bflo(cv[i].w) * bflo(hv[i].w); z[7] = bfhi(cv[i].w) * bfhi(hv[i].w);
#pragma unroll
            for (int j = 0; j < 8; ++j) { y[j] = wt[0][j >> 2][j & 3] * zp[0][j] + wt[1][j >> 2][j & 3] * zp[1][j] + wt[2][j >> 2][j & 3] * z[j]; zp[0][j] = zp[1][j]; zp[1][j] = z[j]; }
            o[i].x = pk2(bflo(bv[i].x) * y[0], bfhi(bv[i].x) * y[1]); o[i].y = pk2(bflo(bv[i].y) * y[2], bfhi(bv[i].y) * y[3]);
            o[i].z = pk2(bflo(bv[i].z) * y[4], bfhi(bv[i].z) * y[5]); o[i].w = pk2(bflo(bv[i].w) * y[6], bfhi(bv[i].w) * y[7]); }
        asm volatile("" ::: "memory");
        if (half == 0) {
        }
#pragma unroll
        for (int i = 0; i < 4; ++i) *(v4u*)(MIX + (size_t)(t0 + 4 * half + i) * DM + 2048 + col) = o[i];
    }
}
__device__ __forceinline__ float prep_sq8(v4u v) { return ((bflo(v.x) * bflo(v.x) + bfhi(v.x) * bfhi(v.x)) + (bflo(v.y) * bflo(v.y) + bfhi(v.y) * bfhi(v.y))) + ((bflo(v.z) * bflo(v.z) + bfhi(v.z) * bfhi(v.z)) + (bflo(v.w) * bflo(v.w) + bfhi(v.w) * bfhi(v.w))); }
__device__ __forceinline__ void prep_rms8(const bf16* PROJ, float* RQ, float* RKV, bf16* KR, const float* COS, const float* SIN, int t0, int lane) {
    v4u a[8], b[8], c[8]; float x1[8], x2[8], cs[8], sn[8]; const int j = lane & 31;
#pragma unroll
    for (int i = 0; i < 8; ++i) { const bf16* prow = PROJ + (size_t)(t0 + i) * INWP;
        a[i] = *(const v4u*)(prow + C_CQ + lane * 8); b[i] = (lane < 32) ? *(const v4u*)(prow + C_CQ + 512 + lane * 8) : (v4u){0u, 0u, 0u, 0u}; c[i] = *(const v4u*)(prow + C_CKV + lane * 8);
        x1[i] = bf2f(prow[C_KR + j]); x2[i] = bf2f(prow[C_KR + 32 + j]); cs[i] = COS[(size_t)(t0 + i) * 32 + j]; sn[i] = SIN[(size_t)(t0 + i) * 32 + j]; }
    float rq[8], rkv[8]; unsigned kr[8];
#pragma unroll
    for (int i = 0; i < 8; ++i) { rq[i] = 1.0f / sqrtf(wave_sum(prep_sq8(a[i]) + prep_sq8(b[i])) * (1.0f / QRANK) + RMS_EPS); rkv[i] = 1.0f / sqrtf(wave_sum(prep_sq8(c[i])) * (1.0f / KVRANK) + RMS_EPS);
        kr[i] = pk2(x1[i] * cs[i] - x2[i] * sn[i], x1[i] * sn[i] + x2[i] * cs[i]); }
    asm volatile("" ::: "memory");
#pragma unroll
    for (int i = 0; i < 8; ++i) { if (lane == 0) { RQ[t0 + i] = rq[i]; RKV[t0 + i] = rkv[i]; } if (lane < 32) *(unsigned*)(KR + (size_t)(t0 + i) * 64 + 2 * lane) = kr[i]; }
}
#undef PREP_ACC8
__device__ __forceinline__ void prep8(const bf16* PROJ, bf16* PD, bf16* MIX, float* RQ, float* RKV, bf16* KR, const float* COS, const float* SIN, const float* convw, int t0, int lane) {
    prep_pool8<0>(PROJ, PD, t0, lane); asm volatile("" ::: "memory");
    prep_pool8<1>(PROJ, PD, t0, lane); asm volatile("" ::: "memory");
    prep_conv8<0>(PROJ, MIX, convw, t0, lane); asm volatile("" ::: "memory");
    prep_conv8<1>(PROJ, MIX, convw, t0, lane); asm volatile("" ::: "memory");
    prep_rms8(PROJ, RQ, RKV, KR, COS, SIN, t0, lane);
}

template <bool IN32, bool OUT32, bool RDLO = true, bool WRLO = true>
__device__ __forceinline__ void ln_phase(const float* xin32, const bf16* YB, float* XOUT32, bf16* XB, unsigned* XL, const float* g, const float* b, LAS unsigned char* lds, int gw, int NGW, int lane, int tid) {
    LAS f32x4* gl = (LAS f32x4*)lds; LAS f32x4* bl = gl + 1024;
    for (int i = tid; i < 1024; i += NWAVES * 64) { gl[i] = *(const f32x4*)(g + 4 * i); bl[i] = *(const f32x4*)(b + 4 * i); }
    __syncthreads();
    typedef float f32x2_t __attribute__((ext_vector_type(2)));
    f32x4 xr[IN32 ? 16 : 1]; unsigned long long xh[IN32 ? 1 : 16]; unsigned xl[IN32 ? 1 : 16]; unsigned long long yr[16];
#define LN_LOAD(mm) do { _Pragma("unroll") for (int j = 0; j < 16; ++j) { const size_t o_ = (size_t)(mm) * DM + 4 * lane + 256 * j; \
            if (IN32) xr[IN32 ? j : 0] = *(const f32x4*)(xin32 + o_); else { xh[IN32 ? 0 : j] = *(const unsigned long long*)(XB + o_); if (RDLO) xl[IN32 ? 0 : j] = XL[o_ >> 2]; } \
            yr[j] = *(const unsigned long long*)(YB + o_); } } while (0)
    int m = gw;
    if (m < M) LN_LOAD(m);
    for (; m < M; m += NGW) {
        f32x4 v[16]; float s = 0.f;
#pragma unroll
        for (int j = 0; j < 16; ++j) { const unsigned y0 = (unsigned)yr[j], y1 = (unsigned)(yr[j] >> 32); f32x4 x;
            if (IN32) x = xr[IN32 ? j : 0];
            else { const unsigned h0 = (unsigned)xh[IN32 ? 0 : j], h1 = (unsigned)(xh[IN32 ? 0 : j] >> 32); const int lw = RDLO ? (int)xl[IN32 ? 0 : j] : 0;
                const f32x2_t l01 = __builtin_amdgcn_cvt_pk_f32_fp8(lw, false), l23 = __builtin_amdgcn_cvt_pk_f32_fp8(lw, true);
                x[0] = bflo(h0) + l01.x * (1.0f / 512.0f); x[1] = bfhi(h0) + l01.y * (1.0f / 512.0f); x[2] = bflo(h1) + l23.x * (1.0f / 512.0f); x[3] = bfhi(h1) + l23.y * (1.0f / 512.0f); }
            v[j][0] = x[0] * ALPHA + bflo(y0); v[j][1] = x[1] * ALPHA + bfhi(y0); v[j][2] = x[2] * ALPHA + bflo(y1); v[j][3] = x[3] * ALPHA + bfhi(y1);
            s += (v[j][0] + v[j][1]) + (v[j][2] + v[j][3]); }
        asm volatile("" ::: "memory");
        const int mn = m + NGW;
        if (mn < M) LN_LOAD(mn);
        asm volatile("" ::: "memory");
        const float mean = wave_sum(s) * (1.0f / DM); float s2 = 0.f;
#pragma unroll
        for (int j = 0; j < 16; ++j) { v[j] = v[j] - mean; s2 += (v[j][0] * v[j][0] + v[j][1] * v[j][1]) + (v[j][2] * v[j][2] + v[j][3] * v[j][3]); }
        const float rstd = 1.0f / sqrtf(wave_sum(s2) * (1.0f / DM) + LN_EPS);
#pragma unroll
        for (int j = 0; j < 16; ++j) { const f32x4 gg = gl[lane + 64 * j], bb = bl[lane + 64 * j]; const size_t o = (size_t)m * DM + 4 * lane + 256 * j;
            const f32x4 y = v[j] * rstd * gg + bb;
            if (OUT32) *(f32x4*)(XOUT32 + o) = y;
            else { const unsigned h0 = pk2(y[0], y[1]), h1 = pk2(y[2], y[3]);
                int lw = 0; lw = __builtin_amdgcn_cvt_pk_fp8_f32((y[0] - bflo(h0)) * 512.0f, (y[1] - bfhi(h0)) * 512.0f, lw, false); lw = __builtin_amdgcn_cvt_pk_fp8_f32((y[2] - bflo(h1)) * 512.0f, (y[3] - bfhi(h1)) * 512.0f, lw, true);
                *(unsigned long long*)(XB + o) = (unsigned long long)h0 | ((unsigned long long)h1 << 32); if (WRLO) XL[o >> 2] = (unsigned)lw; }
            if ((j & 3) == 3) asm volatile("" ::: "memory"); }
    }
#undef LN_LOAD
}

__device__ __forceinline__ void dil_naive_item(const bf16* PROJ, const float* BIAS, bf16* MIX, int t, int h, LAS float* qs, int lane) {
    const bf16* prow = PROJ + (size_t)t * INWP;
    { const unsigned qq = *(const unsigned*)(prow + C_Q + h * 128 + 2 * lane); qs[2 * lane] = bflo(qq); qs[2 * lane + 1] = bfhi(qq); }
    LDS_WAIT(); asm volatile("" ::: "memory");
    float lg[3][3]; float mx = -__builtin_inff();
#pragma unroll
    for (int b = 0; b < 3; ++b)
#pragma unroll
        for (int ps = 0; ps < 3; ++ps) { const int d = 1 << (2 * b), s = lane + 64 * ps, kp = t - s * d; float v = -__builtin_inff();
            if (s <= 128 && kp >= 0) { const bf16* kr = PROJ + (size_t)kp * INWP + C_K + h * 128; float dot = 0.f;
#pragma unroll
                for (int c = 0; c < 16; ++c) { const v4u kv = *(const v4u*)(kr + 8 * c); const f32x4 q0 = *(const LAS f32x4*)(qs + 8 * c), q1 = *(const LAS f32x4*)(qs + 8 * c + 4);
                    dot += bflo(kv.x) * q0[0] + bfhi(kv.x) * q0[1] + bflo(kv.y) * q0[2] + bfhi(kv.y) * q0[3] + bflo(kv.z) * q1[0] + bfhi(kv.z) * q1[1] + bflo(kv.w) * q1[2] + bfhi(kv.w) * q1[3]; }
                v = dot * DIL_SCALE + BIAS[(b * 129 + s) * 8 + h]; }
            lg[b][ps] = v; mx = fmaxf(mx, v); }
    mx = wave_max(mx);
    float den = 0.f;
#pragma unroll
    for (int b = 0; b < 3; ++b)
#pragma unroll
        for (int ps = 0; ps < 3; ++ps) { lg[b][ps] = __expf(lg[b][ps] - mx); den += lg[b][ps]; }
    den = wave_sum(den);
    float o0 = 0.f, o1 = 0.f;
#pragma unroll
    for (int b = 0; b < 3; ++b)
#pragma unroll
        for (int ps = 0; ps < 3; ++ps) { const int d = 1 << (2 * b); const int nl = (ps == 2) ? 1 : 64;
            for (int i = 0; i < nl; ++i) { const int s = i + 64 * ps, kp = t - s * d; if (kp < 0) break;
                const float p = __shfl(lg[b][ps], i); const unsigned vv = *(const unsigned*)(PROJ + (size_t)kp * INWP + C_V + h * 128 + 2 * lane);
                o0 += p * bflo(vv); o1 += p * bfhi(vv); } }
    const float id = 1.0f / den;
    *(unsigned*)(MIX + (size_t)t * DM + 1024 + h * 128 + 2 * lane) = pk2(o0 * id, o1 * id);
    LDS_WAIT(); asm volatile("" ::: "memory");
}

__device__ __forceinline__ void mla_naive_item(const bf16* Q, const bf16* KN, const bf16* KR, const bf16* VT, bf16* MIX, int t, int h, LAS float* qs, int lane) {
    { const bf16* qrow = Q + (size_t)t * 1536 + h * 192; qs[lane] = bf2f(qrow[lane]); qs[lane + 64] = bf2f(qrow[lane + 64]); qs[lane + 128] = bf2f(qrow[lane + 128]); }
    LDS_WAIT(); asm volatile("" ::: "memory");
    float acc[128];
#pragma unroll
    for (int i = 0; i < 128; ++i) acc[i] = 0.f;
    float mrun = -1e30f, lrun = 0.f;
    for (int k0 = 0; k0 <= t; k0 += 64) {
        const int key = k0 + lane; const bool valid = key <= t; float s = -__builtin_inff();
        if (valid) { const bf16* kn = KN + (size_t)key * 1024 + h * 128; const bf16* kr = KR + (size_t)key * 64; float dot = 0.f;
#pragma unroll
            for (int c = 0; c < 16; ++c) { const v4u kv = *(const v4u*)(kn + 8 * c); const f32x4 q0 = *(const LAS f32x4*)(qs + 8 * c), q1 = *(const LAS f32x4*)(qs + 8 * c + 4);
                dot += bflo(kv.x) * q0[0] + bfhi(kv.x) * q0[1] + bflo(kv.y) * q0[2] + bfhi(kv.y) * q0[3] + bflo(kv.z) * q1[0] + bfhi(kv.z) * q1[1] + bflo(kv.w) * q1[2] + bfhi(kv.w) * q1[3]; }
#pragma unroll
            for (int c = 0; c < 8; ++c) { const v4u kv = *(const v4u*)(kr + 8 * c); const f32x4 q0 = *(const LAS f32x4*)(qs + 128 + 8 * c), q1 = *(const LAS f32x4*)(qs + 128 + 8 * c + 4);
                dot += bflo(kv.x) * q0[0] + bfhi(kv.x) * q0[1] + bflo(kv.y) * q0[2] + bfhi(kv.y) * q0[3] + bflo(kv.z) * q1[0] + bfhi(kv.z) * q1[1] + bflo(kv.w) * q1[2] + bfhi(kv.w) * q1[3]; }
            s = dot; }
        const float mnew = fmaxf(mrun, wave_max(s)); const float alpha = __builtin_amdgcn_exp2f(mrun - mnew); const float p = valid ? __builtin_amdgcn_exp2f(s - mnew) : 0.f;
        lrun = lrun * alpha + wave_sum(p); mrun = mnew;
        const bf16* vp = VT + (size_t)(h * 128) * M + (valid ? key : 0);
#pragma unroll
        for (int dv = 0; dv < 128; ++dv) acc[dv] = acc[dv] * alpha + p * bf2f(vp[(size_t)dv * M]);
    }
    float o0 = 0.f, o1 = 0.f;
#pragma unroll
    for (int dv = 0; dv < 128; ++dv) { const float r = wave_sum(acc[dv]); if (lane == (dv & 63)) { if (dv < 64) o0 = r; else o1 = r; } }
    const float il = 1.0f / lrun;
    MIX[(size_t)t * DM + 3072 + h * 128 + lane] = (bf16)f2bf(o0 * il); MIX[(size_t)t * DM + 3072 + h * 128 + 64 + lane] = (bf16)f2bf(o1 * il);
    LDS_WAIT(); asm volatile("" ::: "memory");
}

typedef const __attribute__((address_space(4))) Args* KArgs;
__device__ __forceinline__ KArgs kargs() { KArgs p = (KArgs)__builtin_amdgcn_kernarg_segment_ptr(); asm volatile("" : "+s"(p)); return p; }
#define PHASE_IDS() int tid_ = threadIdx.x; asm volatile("" : "+v"(tid_)); const int lane = tid_ & 63, wave = __builtin_amdgcn_readfirstlane(tid_ >> 6); \
    const int G = gridDim.x, bx = blockIdx.x, vcu = (G % 8 == 0) ? (bx % 8) * (G / 8) + bx / 8 : bx, gw = vcu * NWAVES + wave, NGW = G * NWAVES; (void)lane; (void)gw; (void)NGW; (void)bx
__global__ void __launch_bounds__(NWAVES * 64, 2) fwd(Args args_unused) {
    extern __shared__ __attribute__((aligned(16))) unsigned char lds_raw[];
    LAS unsigned char* lds = (LAS unsigned char*)lds_raw;
    for (int u = threadIdx.x; u < (LDS_BYTES - LDSCTL_OFF) / 4; u += NWAVES * 64) ((LAS unsigned*)(lds + LDSCTL_OFF))[u] = 0u;
    __syncthreads();
#if MK_ONE_LAUNCH
    constexpr int lo = 0, hi = NPHASES;
#else
    int lo, hi;
    { KArgs ka = kargs(); lo = ka->ph_lo; hi = ka->ph_hi; }
#endif
#if MK_ONE_LAUNCH
    { KArgs ka = kargs(); (void)xcd_barrier_post((unsigned*)(ka->ws + WS_CTL) + CW_BAR, (volatile LAS unsigned*)(lds + MISC_OFF) + 8); }
#define MK_BAR() do { KArgs ka_ = kargs(); XcdBarrier bar; bar.bar = (unsigned*)(ka_->ws + WS_CTL) + CW_BAR; bar.x = xb_xcc_id(); bar.st = (volatile LAS unsigned*)(lds + MISC_OFF) + 8; xcd_barrier(bar); } while (0)
#ifdef MK_BAR_TWICE
#define SEAM(k) do { if (IN(k) && IN((k) + 1)) { MK_BAR(); MK_BAR(); } } while (0)
#else
#define SEAM(k) do { if (IN(k) && IN((k) + 1)) MK_BAR(); } while (0)
#endif
#else
#define SEAM(k) do { } while (0)
#endif
#ifndef MK_PHMASK
#define MK_PHMASK 0x3ff
#endif
#define IN(k) (lo <= (k) && (k) < hi)
#define EN(b) (((MK_PHMASK) >> (b)) & 1)
#ifndef MK_REPEAT
#define MK_REPEAT 0
#endif
#define NREP(b) ((((MK_REPEAT) >> (b)) & 1) ? 2 : 1)

    if (EN(9) && IN(0)) { for (int rep = 0; rep < NREP(9); ++rep) { PHASE_IDS(); p0_prologue(kargs(), lds, gw, NGW, wave, lane); } SEAM(0); }

    for (int l = 0; l < DEPTH; ++l) {
        const int p0 = 1 + l * NPH;
        if (EN(0) && IN(p0 + 0)) {
            KArgs ka = kargs(); unsigned char* ws = ka->ws; unsigned char* wl = ws + WS_W + (size_t)l * W_LAYER;
            pg8::Gemm g{(const bf16*)(ws + WS_XB), (const bf16*)(wl + W_IN), M, INWP, DM, DM, 0, 0}; pg8::StaticOrder S; S.init(M, INWP, gridDim.x, blockIdx.x);
            pg8::EpiBf16 E{(bf16*)(ws + WS_PROJ), INWP, nullptr};
            for (int rep = 0; rep < NREP(0); ++rep) pg8::gemm_phase<pg8::EpiBf16, pg8::StaticOrder>(lds + RING_OFF, g, S, E);
            SEAM(p0 + 0);
        }
        if (EN(1) && IN(p0 + 1)) {
#if !MK_NAIVE_DIL
            { KArgs ka = kargs(); unsigned char* ws = ka->ws; dil::pass(lds + RING_OFF, (const bf16*)(ws + WS_PROJ), (const float*)(ws + WS_BIAS), (float*)(ws + WS_DSO), (float*)(ws + WS_DSML), (bf16*)(ws + WS_MIX), 0); if (NREP(5) == 2) dil::pass(lds + RING_OFF, (const bf16*)(ws + WS_PROJ), (const float*)(ws + WS_BIAS), (float*)(ws + WS_DSO), (float*)(ws + WS_DSML), (bf16*)(ws + WS_MIX), 0); }
#endif
            PHASE_IDS(); KArgs ka = kargs(); unsigned char* ws = ka->ws;
            const float* convw = ka->in[5] + (size_t)l * 3 * 1024;
            for (int rep = 0; rep < NREP(1); ++rep)
            for (int tb = gw; tb < M / 8; tb += NGW)
                prep8((const bf16*)(ws + WS_PROJ), (bf16*)(ws + WS_PD), (bf16*)(ws + WS_MIX), (float*)(ws + WS_RQ), (float*)(ws + WS_RKV), (bf16*)(ws + WS_KR), (const float*)(ws + WS_COS), (const float*)(ws + WS_SIN), convw, tb * 8, lane);
            SEAM(p0 + 1);
        }
        if (EN(2) && IN(p0 + 2)) {
#if !MK_NAIVE_DIL
            { KArgs ka = kargs(); unsigned char* ws = ka->ws; dil::pass(lds + RING_OFF, (const bf16*)(ws + WS_PROJ), (const float*)(ws + WS_BIAS), (float*)(ws + WS_DSO), (float*)(ws + WS_DSML), (bf16*)(ws + WS_MIX), 1); }
#endif
            for (int rep = 0; rep < NREP(2); ++rep) {
            { KArgs ka = kargs(); unsigned char* ws = ka->ws; unsigned char* wl = ws + WS_W + (size_t)l * W_LAYER;
              pg8::Gemm g{(const bf16*)(ws + WS_PD), (const bf16*)(wl + W_POOL), M, 1024, 256, 1024, 0, 512}; pg8::StaticOrder S; S.init(M, 1024, gridDim.x, blockIdx.x);
              pg8::EpiBf16 E{(bf16*)(ws + WS_MIX), DM, nullptr};
              pg8::gemm_phase<pg8::EpiBf16, pg8::StaticOrder>(lds + RING_OFF, g, S, E); }
            { KArgs ka = kargs(); unsigned char* ws = ka->ws; unsigned char* wl = ws + WS_W + (size_t)l * W_LAYER;
              pg8::Gemm g{(const bf16*)(ws + WS_PROJ) + C_CQ, (const bf16*)(wl + W_UQ), M, 1536, QRANK, INWP, 0, 0}; pg8::StaticOrder S; S.init(M, 1536, gridDim.x, blockIdx.x);
              pg8::EpiQRope E{(bf16*)(ws + WS_Q), (const float*)(ws + WS_RQ), (const float*)(ws + WS_COS), (const float*)(ws + WS_SIN), QSCALE};
              pg8::gemm_phase<pg8::EpiQRope, pg8::StaticOrder>(lds + RING_OFF, g, S, E); }
            { KArgs ka = kargs(); unsigned char* ws = ka->ws; unsigned char* wl = ws + WS_W + (size_t)l * W_LAYER;
              pg8::Gemm g{(const bf16*)(ws + WS_PROJ) + C_CKV, (const bf16*)(wl + W_UK), M, 1024, KVRANK, INWP, 0, 0}; pg8::StaticOrder S; S.init(M, 1024, gridDim.x, blockIdx.x);
              pg8::EpiBf16 E{(bf16*)(ws + WS_KN), 1024, (const float*)(ws + WS_RKV)};
              pg8::gemm_phase<pg8::EpiBf16, pg8::StaticOrder>(lds + RING_OFF, g, S, E); }
            { KArgs ka = kargs(); unsigned char* ws = ka->ws; unsigned char* wl = ws + WS_W + (size_t)l * W_LAYER;
              pg8::Gemm g{(const bf16*)(wl + W_UV), (const bf16*)(ws + WS_PROJ) + C_CKV, 1024, M, KVRANK, KVRANK, INWP, 0}; pg8::StaticOrder S; S.init(1024, M, gridDim.x, blockIdx.x);
              pg8::EpiBf16ColScale E{(bf16*)(ws + WS_VT), M, (const float*)(ws + WS_RKV)};
              pg8::gemm_phase<pg8::EpiBf16ColScale, pg8::StaticOrder>(lds + RING_OFF, g, S, E); }
            }
            SEAM(p0 + 2);
        }
        if (EN(3) && IN(p0 + 3)) {
#if !MK_NAIVE_DIL
            { KArgs ka = kargs(); unsigned char* ws = ka->ws; dil::pass(lds + RING_OFF, (const bf16*)(ws + WS_PROJ), (const float*)(ws + WS_BIAS), (float*)(ws + WS_DSO), (float*)(ws + WS_DSML), (bf16*)(ws + WS_MIX), 2); }
#else
            { PHASE_IDS(); KArgs ka = kargs(); unsigned char* ws = ka->ws; LAS float* qs = (LAS float*)(lds + RING_OFF + wave * 1024);
              for (int it = gw; it < M * NHEAD; it += NGW) dil_naive_item((const bf16*)(ws + WS_PROJ), (const float*)(ws + WS_BIAS), (bf16*)(ws + WS_MIX), it >> 3, it & 7, qs, lane); }
#endif
#if MK_NAIVE_MLA
            { PHASE_IDS(); KArgs ka = kargs(); unsigned char* ws = ka->ws; LAS float* qs = (LAS float*)(lds + RING_OFF + wave * 1024);
              for (int it = gw; it < M * NHEAD; it += NGW) mla_naive_item((const bf16*)(ws + WS_Q), (const bf16*)(ws + WS_KN), (const bf16*)(ws + WS_KR), (const bf16*)(ws + WS_VT), (bf16*)(ws + WS_MIX), it >> 3, it & 7, qs, lane); }
#else
            { __syncthreads();
              PHASE_IDS(); ConvBg bg; bg.ka = kargs(); bg.slot = lds + (wave < 3 ? mla::AB_LDS_BYTES + wave * 4224 : BGSLOT_HI + (wave - 3) * 4224); bg.lane = lane; bg.l = l; bg.next = gw; bg.stride = NGW; bg.pend = -1; bg.nfly = 0;
              bg.end = MK_MLA_CONV ? 2 * (CV_LATE + (l + 1 < DEPTH ? CV_EARLY : 0)) : 0;
              for (int i = blockIdx.x; i < 256; i += gridDim.x) {
                KArgs ka = kargs(); unsigned char* ws = ka->ws; const int h = i & 7, x = i >> 3;
                mla::unit_ab(lds + RING_OFF, (const bf16*)(ws + WS_Q), (const bf16*)(ws + WS_KN), (const bf16*)(ws + WS_KR), (const bf16*)(ws + WS_VT), (bf16*)(ws + WS_MIX), h, 63 - x, bg);
                mla::unit_ab(lds + RING_OFF, (const bf16*)(ws + WS_Q), (const bf16*)(ws + WS_KN), (const bf16*)(ws + WS_KR), (const bf16*)(ws + WS_VT), (bf16*)(ws + WS_MIX), h, x, bg); }
              bg.drain(); }
#endif
            SEAM(p0 + 3);
        }
        if (EN(4) && IN(p0 + 4)) {
            KArgs ka = kargs(); unsigned char* ws = ka->ws; unsigned char* wl = ws + WS_W + (size_t)l * W_LAYER;
            pg8::Gemm g{(const bf16*)(ws + WS_MIX), (const bf16*)(wl + W_OUT), M, DM, DM, DM, 0, 0}; pg8::StaticOrder S; S.init(M, DM, gridDim.x, blockIdx.x);
            pg8::EpiBf16 E{(bf16*)(ws + WS_YB), DM, nullptr};
            for (int rep = 0; rep < NREP(4); ++rep) pg8::gemm_phase<pg8::EpiBf16, pg8::StaticOrder>(lds + RING_OFF, g, S, E);
            SEAM(p0 + 4);
        }
        if (EN(5) && IN(p0 + 5)) {
            PHASE_IDS(); KArgs ka = kargs(); unsigned char* ws = ka->ws; float* XF = ka->out; const float* xin = (l == 0) ? ka->in[0] : (const float*)XF; bf16* XB = (bf16*)(ws + WS_XB); const bf16* YB = (const bf16*)(ws + WS_YB);
            const float* gg = ka->in[11] + (size_t)l * DM; const float* bb = ka->in[12] + (size_t)l * DM;
            unsigned* XL = (unsigned*)(ws + WS_XL);
            if (l == 0) ln_phase<true, false, false, XL_LN1>(xin, YB, XF, XB, XL, gg, bb, lds + RING_OFF, gw, NGW, lane, tid_);
            else ln_phase<false, false, XL_LN2, XL_LN1>(xin, YB, XF, XB, XL, gg, bb, lds + RING_OFF, gw, NGW, lane, tid_);
            SEAM(p0 + 5);
        }
        if (EN(6) && IN(p0 + 6)) {
            KArgs ka = kargs(); unsigned char* ws = ka->ws; unsigned char* wl = ws + WS_W + (size_t)l * W_LAYER;
            pg8::Gemm g{(const bf16*)(ws + WS_XB), (const bf16*)(wl + W_GU), M, 2 * FFN, DM, DM, 0, 0}; pg8::StaticOrder S; S.init(M, 2 * FFN, gridDim.x, blockIdx.x);
            pg8::EpiSwiGLU E{(bf16*)(ws + WS_HID), FFN};
            for (int rep = 0; rep < NREP(6); ++rep) pg8::gemm_phase<pg8::EpiSwiGLU, pg8::StaticOrder>(lds + RING_OFF, g, S, E);
            SEAM(p0 + 6);
        }
        if (EN(7) && IN(p0 + 7)) {
            KArgs ka = kargs(); unsigned char* ws = ka->ws; unsigned char* wl = ws + WS_W + (size_t)l * W_LAYER;
            pg8::Gemm g{(const bf16*)(ws + WS_HID), (const bf16*)(wl + W_DN), M, DM, FFN, FFN, 0, 0}; pg8::StaticOrder S; S.init(M, DM, gridDim.x, blockIdx.x);
            pg8::EpiBf16 E{(bf16*)(ws + WS_YB), DM, nullptr};
            for (int rep = 0; rep < NREP(7); ++rep) pg8::gemm_phase<pg8::EpiBf16, pg8::StaticOrder>(lds + RING_OFF, g, S, E);
            SEAM(p0 + 7);
        }
        if (EN(8) && IN(p0 + 8)) {
            PHASE_IDS(); KArgs ka = kargs(); unsigned char* ws = ka->ws; float* XF = ka->out; bf16* XB = (bf16*)(ws + WS_XB); const bf16* YB = (const bf16*)(ws + WS_YB);
            const float* gg = ka->in[16] + (size_t)l * DM; const float* bb = ka->in[17] + (size_t)l * DM;
            unsigned* XL = (unsigned*)(ws + WS_XL);
            if (l == DEPTH - 1) ln_phase<false, true, XL_LN1, false>(XF, YB, XF, XB, XL, gg, bb, lds + RING_OFF, gw, NGW, lane, tid_);
            else ln_phase<false, false, XL_LN1, XL_LN2>(XF, YB, XF, XB, XL, gg, bb, lds + RING_OFF, gw, NGW, lane, tid_);
            SEAM(p0 + 8);
        }
    }
#undef IN
#undef SEAM
#undef EN
}

extern "C" void kernel_launch(void* const* d_in, const int* in_sizes, int n_in, void* d_out, int out_size, void* d_ws, size_t ws_size, hipStream_t stream) {
    static int grid = 0;
    if (grid == 0) {
        if (n_in != 18 || in_sizes[0] != M * DM || out_size != M * DM || ws_size < WS_END) { fprintf(stderr, "kernel_launch: unexpected shapes (n_in %d, in0 %d, out %d, ws %zu < %zu); nothing launched\n", n_in, n_in > 0 ? in_sizes[0] : -1, out_size, ws_size, (size_t)WS_END); grid = -1; return; }
        int dev = 0, cus = 0, per_cu = 0;
        if (hipGetDevice(&dev) != hipSuccess || hipDeviceGetAttribute(&cus, hipDeviceAttributeMultiprocessorCount, dev) != hipSuccess) { fprintf(stderr, "kernel_launch: device query failed\n"); grid = -1; return; }
        if (hipFuncSetAttribute((const void*)fwd, hipFuncAttributeMaxDynamicSharedMemorySize, LDS_BYTES) != hipSuccess) { fprintf(stderr, "kernel_launch: hipFuncSetAttribute failed\n"); grid = -1; return; }
        if (hipOccupancyMaxActiveBlocksPerMultiprocessor(&per_cu, (const void*)fwd, NWAVES * 64, LDS_BYTES) != hipSuccess || per_cu < 1) { fprintf(stderr, "kernel_launch: occupancy query reports %d workgroups per CU\n", per_cu); }
        (void)hipGetLastError();
        grid = cus;
    }
    if (grid < 0) return;
    if (hipMemsetAsync((char*)d_ws + WS_CTL, 0, CTL_ZERO_BYTES, stream) != hipSuccess) { fprintf(stderr, "kernel_launch: memset failed\n"); return; }
    Args a{};
    for (int i = 0; i < 18; ++i) a.in[i] = (const float*)d_in[i];
    a.out = (float*)d_out; a.ws = (unsigned char*)d_ws;
    for (int j = 0; j < 32; ++j) a.inv[j] = (float)pow(10000.0, -(double)(2 * j) / 64.0);
#if MK_ONE_LAUNCH
    a.ph_lo = 0; a.ph_hi = NPHASES;
    hipLaunchKernelGGL(fwd, dim3(grid), dim3(NWAVES * 64), LDS_BYTES, stream, a);
#else
    for (int p = 0; p < NPHASES; ++p) { a.ph_lo = p; a.ph_hi = p + 1; hipLaunchKernelGGL(fwd, dim3(grid), dim3(NWAVES * 64), LDS_BYTES, stream, a); }
#endif
    const hipError_t le = hipPeekAtLastError();
    if (le != hipSuccess) fprintf(stderr, "kernel_launch: launch failed: %s\n", hipGetErrorName(le));
}
```
